# Optimizing an MI355X kernel written in HIP

```python
import jax, jax.numpy as jnp
from jax import lax
import numpy as np

D_MODEL = 1024
BATCH = 2
SEQ = 8192
DEPTH = 2

N_MIXERS = 2
N_POOL_LAYERS = (DEPTH + 1) // 2
N_MLA_LAYERS = DEPTH // 2
DEEPNORM_ALPHA = (2 * DEPTH) ** 0.25
DEEPNORM_BETA = (8 * DEPTH) ** -0.25
LN_EPS = 1e-5
RMS_EPS = 1e-6
POOL_WINDOWS = (2, 4, 8, 16)
POOL_GROUPS = 4
POOL_CH = D_MODEL // POOL_GROUPS
N_HEADS = 8
Q_LORA = 384
KV_LORA = 256
QK_NOPE = 128
QK_ROPE = 64
V_HEAD = 128
ROPE_THETA = 10000.0
Q_BLOCK = 128
N_EXPERTS = 256
TOP_K = 8
N_GROUPS = 8
TOPK_GROUPS = 4
EXPERT_FF = 256
SHARED_FF = 256
ROUTED_SCALE = 2.5
DISPATCH_BLOCK = 128

kernel_name = "hybrid_pool_mla_moe_deepnorm"

F32 = jnp.float32


def layer_norm(x, g, b):
    xf = x.astype(F32)
    mu = jnp.mean(xf, axis=-1, keepdims=True)
    var = jnp.mean(jnp.square(xf - mu), axis=-1, keepdims=True)
    return ((xf - mu) * lax.rsqrt(var + LN_EPS) * g.astype(F32) + b.astype(F32)).astype(x.dtype)


def rms_norm(x, g):
    xf = x.astype(F32)
    y = xf * lax.rsqrt(jnp.mean(jnp.square(xf), axis=-1, keepdims=True) + RMS_EPS)
    return (y * g.astype(F32)).astype(x.dtype)


def rope_tables(seq):
    pos = jnp.arange(seq, dtype=F32)
    inv = 1.0 / (ROPE_THETA ** (jnp.arange(0, QK_ROPE, 2, dtype=F32) / QK_ROPE))
    ang = pos[:, None] * inv[None, :]
    return jnp.cos(ang), jnp.sin(ang)


def apply_rope(x, cos, sin):
    xf = x.astype(F32)
    x1, x2 = jnp.split(xf, 2, axis=-1)
    return jnp.concatenate([x1 * cos - x2 * sin, x1 * sin + x2 * cos], axis=-1).astype(x.dtype)


def pool_mixer(x, w_pool, b_pool, scale):
    B, S, D = x.shape
    xg = x.astype(F32).reshape(B, S, POOL_GROUPS, POOL_CH)
    csum = jnp.concatenate([jnp.zeros((B, 1, POOL_GROUPS, POOL_CH), F32), jnp.cumsum(xg, axis=1)], axis=1)
    half = jnp.array(POOL_WINDOWS, jnp.int32) // 2
    pos = jnp.arange(S, dtype=jnp.int32)[:, None]
    lo = jnp.clip(pos - half[None, :], 0, S)
    hi = jnp.clip(pos + half[None, :], 0, S)
    gi = jnp.arange(POOL_GROUPS)[None, :]
    win_sum = csum[:, hi, gi, :] - csum[:, lo, gi, :]
    count = (hi - lo).astype(F32)[None, :, :, None]
    pooled = (win_sum / count - xg).astype(x.dtype)
    y = jnp.einsum('bsgc,gcd->bsgd', pooled, w_pool).reshape(B, S, D) + b_pool
    return y * scale


def mla_mixer(x, w_a, q_norm_g, kv_norm_g, w_uq, w_uk, w_uv, w_o):
    B, S, D = x.shape
    a = x @ w_a
    q_lat = rms_norm(a[..., :Q_LORA], q_norm_g)
    kv_lat = rms_norm(a[..., Q_LORA:Q_LORA + KV_LORA], kv_norm_g)
    cos, sin = rope_tables(S)
    k_rope = apply_rope(a[..., Q_LORA + KV_LORA:], cos, sin)
    q = jnp.einsum('bsl,lhd->bshd', q_lat, w_uq)
    q_nope = q[..., :QK_NOPE]
    q_rope = apply_rope(q[..., QK_NOPE:], cos[:, None, :], sin[:, None, :])
    k_nope = jnp.einsum('bsl,lhd->bshd', kv_lat, w_uk)
    v = jnp.einsum('bsl,lhd->bshd', kv_lat, w_uv)
    sm_scale = (QK_NOPE + QK_ROPE) ** -0.5
    nb = S // Q_BLOCK
    qn_b = q_nope.reshape(B, nb, Q_BLOCK, N_HEADS, QK_NOPE).transpose(1, 0, 2, 3, 4)
    qr_b = q_rope.reshape(B, nb, Q_BLOCK, N_HEADS, QK_ROPE).transpose(1, 0, 2, 3, 4)

    def attend(blk):
        qn, qr = blk
        s = (jnp.einsum('bqhd,bkhd->bhqk', qn, k_nope, preferred_element_type=F32)
             + jnp.einsum('bqhd,bkd->bhqk', qr, k_rope, preferred_element_type=F32)) * sm_scale
        p = jax.nn.softmax(s, axis=-1).astype(v.dtype)
        return jnp.einsum('bhqk,bkhd->bqhd', p, v)

    o = lax.map(attend, (qn_b, qr_b))
    o = o.transpose(1, 0, 2, 3, 4).reshape(B, S, N_HEADS * V_HEAD)
    return o @ w_o


def moe_ffn(h, router_w, router_b, w_gate, w_up, w_down, s_gate, s_up, s_down):
    B, S, D = h.shape
    t = h.reshape(-1, D)
    N = t.shape[0]
    scores = jax.nn.sigmoid(jnp.dot(t, router_w, preferred_element_type=F32))
    biased = scores + router_b.astype(F32)
    per = N_EXPERTS // N_GROUPS
    group_score = lax.top_k(biased.reshape(N, N_GROUPS, per), 2)[0].sum(-1)
    _, gsel = lax.top_k(group_score, TOPK_GROUPS)
    gmask = jax.nn.one_hot(gsel, N_GROUPS, dtype=F32).sum(1) > 0
    emask = jnp.repeat(gmask, per, axis=1)
    _, eidx = lax.top_k(jnp.where(emask, biased, -jnp.inf), TOP_K)
    gate = jnp.take_along_axis(scores, eidx, axis=1)
    gate = gate / jnp.sum(gate, axis=-1, keepdims=True) * ROUTED_SCALE

    A = N * TOP_K
    flat_e = eidx.reshape(-1)
    order = jnp.argsort(flat_e)
    sorted_e = flat_e[order]
    counts = jnp.bincount(flat_e, length=N_EXPERTS)
    padded = (counts + DISPATCH_BLOCK - 1) // DISPATCH_BLOCK * DISPATCH_BLOCK
    start = jnp.cumsum(counts) - counts
    pend = jnp.cumsum(padded)
    pstart = pend - padded
    dest = pstart[sorted_e] + jnp.arange(A, dtype=jnp.int32) - start[sorted_e]
    n_blocks = -(-(A + N_EXPERTS * (DISPATCH_BLOCK - 1)) // DISPATCH_BLOCK)
    P = n_blocks * DISPATCH_BLOCK
    slot_tok = jnp.full((P,), N, jnp.int32).at[dest].set((order // TOP_K).astype(jnp.int32))
    slot_gate = jnp.zeros((P,), F32).at[dest].set(gate.reshape(-1)[order])
    blk_start = jnp.arange(n_blocks, dtype=jnp.int32) * DISPATCH_BLOCK
    blk_exp = jnp.minimum(jnp.searchsorted(pend, blk_start, side='right'), N_EXPERTS - 1)
    t_pad = jnp.concatenate([t, jnp.zeros((1, D), t.dtype)], axis=0)

    def body(acc, blk):
        idx, g, e = blk
        xb = t_pad[idx]
        hb = jax.nn.silu(xb @ w_gate[e]) * (xb @ w_up[e])
        yb = jnp.dot(hb, w_down[e], preferred_element_type=F32) * g[:, None]
        return acc.at[idx].add(yb), None

    acc, _ = lax.scan(body, jnp.zeros((N + 1, D), F32),
                      (slot_tok.reshape(n_blocks, DISPATCH_BLOCK),
                       slot_gate.reshape(n_blocks, DISPATCH_BLOCK), blk_exp))
    shared = (jax.nn.silu(t @ s_gate) * (t @ s_up)) @ s_down
    return (acc[:N] + shared.astype(F32)).astype(h.dtype).reshape(B, S, D)


def setup_inputs(seed: int = 0) -> dict:
    key = jax.random.key(seed)
    ks = jax.random.split(key, 24)
    D = D_MODEL
    beta = DEEPNORM_BETA

    def nrm(k, shape, s):
        return jax.random.normal(k, shape, F32) * s

    def gain(k, shape):
        return 1.0 + 0.02 * jax.random.normal(k, shape, F32)

    return {
        "x": nrm(ks[0], (BATCH, SEQ, D), 1.0),
        "pool_w": nrm(ks[1], (N_POOL_LAYERS, POOL_GROUPS, POOL_CH, POOL_CH), POOL_CH ** -0.5 * beta),
        "pool_b": nrm(ks[2], (N_POOL_LAYERS, D), 0.01),
        "pool_scale": gain(ks[3], (N_POOL_LAYERS, D)),
        "mla_w_a": nrm(ks[4], (N_MLA_LAYERS, D, Q_LORA + KV_LORA + QK_ROPE), D ** -0.5),
        "mla_q_norm_g": gain(ks[5], (N_MLA_LAYERS, Q_LORA)),
        "mla_kv_norm_g": gain(ks[6], (N_MLA_LAYERS, KV_LORA)),
        "mla_w_uq": nrm(ks[7], (N_MLA_LAYERS, Q_LORA, N_HEADS, QK_NOPE + QK_ROPE), Q_LORA ** -0.5),
        "mla_w_uk": nrm(ks[8], (N_MLA_LAYERS, KV_LORA, N_HEADS, QK_NOPE), KV_LORA ** -0.5),
        "mla_w_uv": nrm(ks[9], (N_MLA_LAYERS, KV_LORA, N_HEADS, V_HEAD), KV_LORA ** -0.5 * beta),
        "mla_w_o": nrm(ks[10], (N_MLA_LAYERS, N_HEADS * V_HEAD, D), (N_HEADS * V_HEAD) ** -0.5 * beta),
        "ln_mix_g": gain(ks[11], (DEPTH, D)),
        "ln_mix_b": nrm(ks[12], (DEPTH, D), 0.01),
        "router_w": nrm(ks[13], (DEPTH, D, N_EXPERTS), D ** -0.5),
        "router_b": nrm(ks[14], (DEPTH, N_EXPERTS), 0.01),
        "exp_w_gate": nrm(ks[15], (DEPTH, N_EXPERTS, D, EXPERT_FF), D ** -0.5),
        "exp_w_up": nrm(ks[16], (DEPTH, N_EXPERTS, D, EXPERT_FF), D ** -0.5),
        "exp_w_down": nrm(ks[17], (DEPTH, N_EXPERTS, EXPERT_FF, D), EXPERT_FF ** -0.5 * beta),
        "sh_w_gate": nrm(ks[18], (DEPTH, D, SHARED_FF), D ** -0.5),
        "sh_w_up": nrm(ks[19], (DEPTH, D, SHARED_FF), D ** -0.5),
        "sh_w_down": nrm(ks[20], (DEPTH, SHARED_FF, D), SHARED_FF ** -0.5 * beta),
        "ln_ffn_g": gain(ks[21], (DEPTH, D)),
        "ln_ffn_b": nrm(ks[22], (DEPTH, D), 0.01),
    }


def reference(x, pool_w, pool_b, pool_scale, mla_w_a, mla_q_norm_g, mla_kv_norm_g, mla_w_uq,
              mla_w_uk, mla_w_uv, mla_w_o, ln_mix_g, ln_mix_b, router_w, router_b, exp_w_gate,
              exp_w_up, exp_w_down, sh_w_gate, sh_w_up, sh_w_down, ln_ffn_g, ln_ffn_b):
    h = x
    for i in range(DEPTH):
        j = i // N_MIXERS
        if i % N_MIXERS == 0:
            m = pool_mixer(h, pool_w[j], pool_b[j], pool_scale[j])
        else:
            m = mla_mixer(h, mla_w_a[j], mla_q_norm_g[j], mla_kv_norm_g[j], mla_w_uq[j],
                          mla_w_uk[j], mla_w_uv[j], mla_w_o[j])
        h = layer_norm(DEEPNORM_ALPHA * h + m, ln_mix_g[i], ln_mix_b[i])
        f = moe_ffn(h, router_w[i], router_b[i], exp_w_gate[i], exp_w_up[i], exp_w_down[i],
                    sh_w_gate[i], sh_w_up[i], sh_w_down[i])
        h = layer_norm(DEEPNORM_ALPHA * h + f, ln_ffn_g[i], ln_ffn_b[i])
    return h
```

```cpp
#include <hip/hip_runtime.h>
#include <stdint.h>
#include <stdio.h>

#ifndef MK_SINGLE
#define MK_SINGLE 1
#endif
#ifndef DBG
#define DBG 0
#endif

constexpr int NTOK = 16384, DM = 1024, SEQ = 8192;
constexpr int NEXP = 256, EFF = 256, TOPK = 8;
constexpr int QL = 384, KVL = 256, NH = 8, DQK = 192, DNOPE = 128, DROPE = 64, DVH = 128;
constexpr int WA_N = 704, WA_NP = 768;
constexpr float ALPHA = 1.4142135623730951f;
constexpr float LN_EPS = 1e-5f, RMS_EPS = 1e-6f;
constexpr int NTHR = 512;

typedef unsigned short bf16_t;
typedef __attribute__((ext_vector_type(8))) short bf16x8;
typedef __attribute__((ext_vector_type(4))) short s16x4;
typedef __attribute__((ext_vector_type(16))) float f32x16;
typedef __attribute__((ext_vector_type(4))) float f32x4;
typedef __attribute__((ext_vector_type(2))) float f32x2;
typedef __attribute__((ext_vector_type(4))) unsigned u32x4;
typedef __attribute__((ext_vector_type(2))) unsigned u32x2;

constexpr size_t al256(size_t x) { return (x + 255) / 256 * 256; }
constexpr size_t OFF_BAR = 0;
constexpr size_t OFF_DBG = 16384;
constexpr size_t OFF_CNT = 32768;
constexpr size_t OFF_ROPE = 65536;
constexpr size_t OFF_WPOOL = OFF_ROPE + 2 * (size_t)SEQ * 32 * 4;
constexpr size_t OFF_WR = OFF_WPOOL + (size_t)4 * 256 * 256 * 2;
constexpr size_t OFF_WA = OFF_WR + (size_t)2 * DM * NEXP * 2;
constexpr size_t OFF_WUQ = OFF_WA + (size_t)DM * WA_NP * 2;
constexpr size_t OFF_WUK = OFF_WUQ + (size_t)QL * 1536 * 2;
constexpr size_t OFF_WUV = OFF_WUK + (size_t)KVL * 1024 * 2;
constexpr size_t OFF_WO = OFF_WUV + (size_t)KVL * 1024 * 2;
constexpr size_t OFF_SWG = OFF_WO + (size_t)DM * DM * 2;
constexpr size_t OFF_SWU = OFF_SWG + (size_t)2 * DM * EFF * 2;
constexpr size_t OFF_SWD = OFF_SWU + (size_t)2 * DM * EFF * 2;
constexpr size_t OFF_POOLED = OFF_SWD + (size_t)2 * EFF * DM * 2;
constexpr size_t OFF_Z = OFF_POOLED + (size_t)NTOK * DM * 2;
constexpr size_t OFF_H0F = OFF_Z + (size_t)NTOK * DM * 4;
constexpr size_t OFF_H0B = OFF_H0F + (size_t)NTOK * DM * 4;
constexpr size_t OFF_H1F = OFF_H0B + (size_t)NTOK * DM * 2;
constexpr size_t OFF_H1B = OFF_H1F + (size_t)NTOK * DM * 4;
constexpr size_t OFF_LOGIT = OFF_H1B + (size_t)NTOK * DM * 2;
constexpr size_t OFF_LIST = OFF_LOGIT + (size_t)NTOK * NEXP * 4;
constexpr size_t OFF_GATE = OFF_LIST + (size_t)NEXP * NTOK * 4;
constexpr size_t OFF_TEXP = OFF_GATE + (size_t)NTOK * TOPK * 4;
constexpr size_t OFF_Y = OFF_TEXP + (size_t)NTOK * TOPK * 4;
constexpr size_t OFF_YSH = OFF_Y + (size_t)NTOK * TOPK * DM * 2;
constexpr size_t OFF_ABUF = OFF_YSH + (size_t)NTOK * DM * 2;
constexpr size_t OFF_QLAT = OFF_ABUF + (size_t)NTOK * WA_NP * 4;
constexpr size_t OFF_KVLAT = OFF_QLAT + (size_t)NTOK * QL * 2;
constexpr size_t OFF_Q = OFF_KVLAT + (size_t)NTOK * KVL * 2;
constexpr size_t OFF_K = OFF_Q + (size_t)NTOK * 1536 * 2;
constexpr size_t OFF_V = OFF_K + (size_t)NTOK * 1536 * 2;
constexpr size_t OFF_O = OFF_V + (size_t)NTOK * 1024 * 2;
constexpr size_t WS_END = OFF_O + (size_t)NTOK * 1024 * 2;

struct Params {
  const float *x, *pool_w, *pool_b, *pool_scale, *w_a, *qn_g, *kvn_g, *w_uq, *w_uk, *w_uv, *w_o;
  const float *ln_mix_g, *ln_mix_b, *router_w, *router_b, *ew_gate, *ew_up, *ew_down, *sw_gate, *sw_up, *sw_down, *ln_ffn_g, *ln_ffn_b;
  float* out;
  char* ws;
};

#define XB_TMO      128
#define XB_XCNT(j)  (256  + 64 * (j))
#define XB_XSUB(j)  (1280 + 64 * (j))
#define XB_XGEN(j)  (2304 + 64 * (j))
#define XB_TOP      3328
#define XB_TOPGEN   3392
#define XCD_BAR_WORDS 3456
#define XB_SPIN_CAP (1u << 20)
#define LAS __attribute__((address_space(3)))

__device__ __forceinline__ unsigned xb_ld(unsigned* p)              { return __hip_atomic_load(p, __ATOMIC_RELAXED, __HIP_MEMORY_SCOPE_AGENT); }
__device__ __forceinline__ unsigned xb_add(unsigned* p, unsigned v) { return __hip_atomic_fetch_add(p, v, __ATOMIC_RELAXED, __HIP_MEMORY_SCOPE_AGENT); }
__device__ __forceinline__ unsigned xb_xcc_id() { return (unsigned)__builtin_amdgcn_s_getreg((3 << 11) | 20) & 0xFu; }
#define XB_SPIN(cond, bar) do { unsigned _sp = 0; while (cond) { __builtin_amdgcn_s_sleep(1); \
    if ((++_sp & 255u) == 0u) { if (xb_ld(&(bar)[XB_TMO])) break; if (_sp > XB_SPIN_CAP) { atomicAdd(&(bar)[XB_TMO], 1u); break; } } } } while (0)

struct XcdBarrier { unsigned* bar; unsigned x; volatile LAS unsigned* st; };

__device__ __forceinline__ XcdBarrier xcd_barrier_post(unsigned* bar, volatile LAS unsigned* st) {
    XcdBarrier b; b.bar = bar; b.x = xb_xcc_id(); b.st = st;
    if (threadIdx.x == 0) (void)xb_add(&bar[XB_XCNT(b.x)], 1u);
    return b;
}
__device__ __forceinline__ void xcd_barrier_complete(unsigned* bar, unsigned x, unsigned& nloc, unsigned& nx) {
    const unsigned G = gridDim.x * gridDim.y * gridDim.z;
    unsigned sum, cnt, mine, sp = 0u;
    for (;;) {
        sum = 0u; cnt = 0u; mine = 0u;
#pragma unroll
        for (unsigned j = 0; j < 16; ++j) { const unsigned c = xb_ld(&bar[XB_XCNT(j)]); sum += c; cnt += (c > 0u) ? 1u : 0u; mine = (j == x) ? c : mine; }
        if (sum == G) break;
        __builtin_amdgcn_s_sleep(1);
        if ((++sp & 255u) == 0u) { if (xb_ld(&bar[XB_TMO])) break; if (sp > XB_SPIN_CAP) { atomicAdd(&bar[XB_TMO], 1u); break; } }
    }
    nloc = mine > 0u ? mine : 1u; nx = cnt > 0u ? cnt : 1u;
}
__device__ __forceinline__ void xcd_barrier(const XcdBarrier& b) {
    asm volatile("s_waitcnt vmcnt(0)" ::: "memory");
    __syncthreads();
    if (threadIdx.x == 0) {
        unsigned* bar = b.bar;
        __builtin_amdgcn_s_waitcnt(0);
        unsigned nloc = b.st[0], nx = b.st[1];
        if (nloc == 0u) { xcd_barrier_complete(bar, b.x, nloc, nx); b.st[0] = nloc; b.st[1] = nx; }
        const unsigned old = xb_add(&bar[XB_XSUB(b.x)], 1u);
        const unsigned gen = old / nloc;
        if (old + 1u == (gen + 1u) * nloc) {
            __builtin_amdgcn_fence(__ATOMIC_RELEASE, "agent");
            asm volatile("s_waitcnt vmcnt(0)" ::: "memory");
            const unsigned og = xb_add(&bar[XB_TOP], 1u);
            const unsigned tg = og / nx;
            if (og + 1u == (tg + 1u) * nx) xb_add(&bar[XB_TOPGEN], 1u);
            else XB_SPIN(xb_ld(&bar[XB_TOPGEN]) == tg, bar);
            __builtin_amdgcn_fence(__ATOMIC_ACQUIRE, "agent");
            xb_add(&bar[XB_XGEN(b.x)], 1u);
            asm volatile("s_waitcnt vmcnt(0)" ::: "memory");
        } else {
            XB_SPIN(xb_ld(&bar[XB_XGEN(b.x)]) == gen, bar);
            __builtin_amdgcn_fence(__ATOMIC_ACQUIRE, "agent");
            asm volatile("s_waitcnt vmcnt(0)" ::: "memory");
        }
    }
    __syncthreads();
}

__device__ __forceinline__ int opaque_tid() { int t = threadIdx.x; asm volatile("" : "+v"(t)); return t; }
#define SBAR() __builtin_amdgcn_sched_barrier(0)
__device__ __forceinline__ int crow(int r, int hi) { return (r & 3) + 8 * (r >> 2) + 4 * hi; }
__device__ __forceinline__ unsigned cvtpk(float lo, float hi) {
  unsigned r; asm("v_cvt_pk_bf16_f32 %0, %1, %2" : "=v"(r) : "v"(lo), "v"(hi)); return r;
}
__device__ __forceinline__ bf16_t f2bf(float f) { return (bf16_t)(cvtpk(f, 0.f) & 0xffffu); }
__device__ __forceinline__ float bf2f(bf16_t b) { return __uint_as_float(((unsigned)b) << 16); }
__device__ __forceinline__ bf16x8 cvt8(f32x4 a, f32x4 b) {
  u32x4 w = {cvtpk(a[0], a[1]), cvtpk(a[2], a[3]), cvtpk(b[0], b[1]), cvtpk(b[2], b[3])};
  return *reinterpret_cast<bf16x8*>(&w);
}
__device__ __forceinline__ float wave_sum(float v) {
#pragma unroll
  for (int o = 32; o > 0; o >>= 1) v += __shfl_xor(v, o);
  return v;
}
__device__ __forceinline__ float wave_max(float v) {
#pragma unroll
  for (int o = 32; o > 0; o >>= 1) v = fmaxf(v, __shfl_xor(v, o));
  return v;
}

template <int BK> __device__ __forceinline__ int a_off(int row, int chunk) {
  if (BK == 32) return row * 64 + ((chunk ^ ((row >> 2) & 3)) << 4);
  else          return row * 128 + ((chunk ^ ((row >> 1) & 7)) << 4);
}
__device__ __forceinline__ int hb_off(int row, int chunk) { return row * 512 + ((chunk ^ (row & 15)) << 4); }
template <int BN> __device__ __forceinline__ int b_st_off(int k, int c) {
  const int kk = (k & ~0xC) | ((k & 4) << 1) | ((k & 8) >> 1);
  return ((kk >> 3) * (BN / 32) + (c >> 5)) * 512 + ((kk & 7) * 32 + (c & 31)) * 2;
}
__device__ __forceinline__ int v_rd_base(int lane) { return ((lane & 3) << 3) | (((lane >> 2) & 3) << 6) | (((lane >> 4) & 1) << 5) | (((lane >> 5) & 1) << 8); }
template <int OFF> __device__ __forceinline__ s16x4 tr_read(int addr) {
  s16x4 r; asm volatile("ds_read_b64_tr_b16 %0, %1 offset:%2" : "=&v"(r) : "v"(addr), "i"(OFF) : "memory"); return r;
}
#define PKF(L, H) (bf16x8){L[0], L[1], L[2], L[3], H[0], H[1], H[2], H[3]}

template <int BN, int BK> struct GC {
  static constexpr int NB = BN / 128;
  static constexpr int CH = BK / 8;
  static constexpr int A_BYTES = 128 * BK * 2;
  static constexpr int B_BYTES = BK * BN * 2;
  static constexpr int STAGE = A_BYTES + B_BYTES;
  static constexpr int BP = BK * BN / 4096;
  static constexpr int AP = 128 * CH / 512;
  static constexpr int CPR = BN / 8;
  static constexpr int RSTEP = 512 / CPR;
};

template <int BN, int S, bool SWAP, bool DUAL>
__device__ __forceinline__ void kstep(f32x16 (&acc)[2][BN / 128], bf16x8 a0, bf16x8 a1, int bb0, int bb1) {
  constexpr int NB = BN / 128;
  constexpr int RS = (BN / 32) * 512;
  constexpr int O0 = (2 * S) * RS, O1 = (2 * S + 1) * RS;
  bf16x8 bf[2];
  if constexpr (NB == 2) {
    s16x4 l0 = tr_read<O0>(bb0), h0 = tr_read<O1>(bb0), l1 = tr_read<O0 + 512>(bb0), h1 = tr_read<O1 + 512>(bb0);
    asm volatile("s_waitcnt lgkmcnt(0)" ::: "memory"); SBAR();
    bf[0] = PKF(l0, h0); bf[1] = PKF(l1, h1);
  } else {
    {
      s16x4 l0 = tr_read<O0>(bb0), h0 = tr_read<O1>(bb0), l1 = tr_read<O0 + 512>(bb0), h1 = tr_read<O1 + 512>(bb0);
      asm volatile("s_waitcnt lgkmcnt(0)" ::: "memory"); SBAR();
      bf[0] = PKF(l0, h0); bf[1] = PKF(l1, h1);
    }
#pragma unroll
    for (int j = 0; j < 2; ++j) {
      if constexpr (SWAP) {
        acc[0][j] = __builtin_amdgcn_mfma_f32_32x32x16_bf16(bf[j], a0, acc[0][j], 0, 0, 0);
        acc[1][j] = __builtin_amdgcn_mfma_f32_32x32x16_bf16(bf[j], a1, acc[1][j], 0, 0, 0);
      } else {
        acc[0][j] = __builtin_amdgcn_mfma_f32_32x32x16_bf16(a0, bf[j], acc[0][j], 0, 0, 0);
        acc[1][j] = __builtin_amdgcn_mfma_f32_32x32x16_bf16(a1, bf[j], acc[1][j], 0, 0, 0);
      }
    }
    {
      s16x4 l2, h2, l3, h3;
      if constexpr (DUAL) { l2 = tr_read<O0>(bb1); h2 = tr_read<O1>(bb1); l3 = tr_read<O0 + 512>(bb1); h3 = tr_read<O1 + 512>(bb1); }
      else { l2 = tr_read<O0 + 1024>(bb0); h2 = tr_read<O1 + 1024>(bb0); l3 = tr_read<O0 + 1536>(bb0); h3 = tr_read<O1 + 1536>(bb0); }
      asm volatile("s_waitcnt lgkmcnt(0)" ::: "memory"); SBAR();
      bf[0] = PKF(l2, h2); bf[1] = PKF(l3, h3);
    }
#pragma unroll
    for (int j = 0; j < 2; ++j) {
      if constexpr (SWAP) {
        acc[0][j + 2] = __builtin_amdgcn_mfma_f32_32x32x16_bf16(bf[j], a0, acc[0][j + 2], 0, 0, 0);
        acc[1][j + 2] = __builtin_amdgcn_mfma_f32_32x32x16_bf16(bf[j], a1, acc[1][j + 2], 0, 0, 0);
      } else {
        acc[0][j + 2] = __builtin_amdgcn_mfma_f32_32x32x16_bf16(a0, bf[j], acc[0][j + 2], 0, 0, 0);
        acc[1][j + 2] = __builtin_amdgcn_mfma_f32_32x32x16_bf16(a1, bf[j], acc[1][j + 2], 0, 0, 0);
      }
    }
    return;
  }
#pragma unroll
  for (int j = 0; j < 2; ++j) {
    if constexpr (SWAP) {
      acc[0][j] = __builtin_amdgcn_mfma_f32_32x32x16_bf16(bf[j], a0, acc[0][j], 0, 0, 0);
      acc[1][j] = __builtin_amdgcn_mfma_f32_32x32x16_bf16(bf[j], a1, acc[1][j], 0, 0, 0);
    } else {
      acc[0][j] = __builtin_amdgcn_mfma_f32_32x32x16_bf16(a0, bf[j], acc[0][j], 0, 0, 0);
      acc[1][j] = __builtin_amdgcn_mfma_f32_32x32x16_bf16(a1, bf[j], acc[1][j], 0, 0, 0);
    }
  }
}

template <int BN, int BK, bool SWAP, bool AHB, bool DUAL, typename TB>
__device__ __forceinline__ void gemm_core(f32x16 (&acc)[2][BN / 128], const char* abase, unsigned aoff0, unsigned aoff1,
                                          const char* bbase, unsigned boff, unsigned ldbB, int bk0, int bc, int NT, char* stage, const char* hb) {
  using C = GC<BN, BK>;
  constexpr bool BF32 = sizeof(TB) == 4;
  constexpr int ABYTES = AHB ? 0 : C::A_BYTES;
  constexpr int STG = ABYTES + C::B_BYTES;
  const int tid = opaque_tid(), lane = tid & 63, wid = tid >> 6, r32 = lane & 31, hi = lane >> 5;
  const int wm = wid >> 2, wn = wid & 3;
  int ast0 = 0, ast1 = 0;
  if constexpr (!AHB) { ast0 = a_off<BK>(tid / C::CH, tid % C::CH); if constexpr (C::AP == 2) ast1 = a_off<BK>((512 + tid) / C::CH, (512 + tid) % C::CH); }
  const int bst0 = ABYTES + b_st_off<BN>(bk0, bc);
  const int row0 = wm * 64 + r32, row1 = row0 + 32;
  int bb0, bb1;
  if constexpr (DUAL) { bb0 = v_rd_base(lane) + (2 * wn) * 512; bb1 = v_rd_base(lane) + (8 + 2 * wn) * 512; }
  else { bb0 = v_rd_base(lane) + (wn * C::NB) * 512; bb1 = bb0; }
  const int sbase = (int)(uintptr_t)stage;
  bb0 += sbase + ABYTES; bb1 += sbase + ABYTES;

  u32x4 areg[C::AP];
  u32x4 breg[C::BP * (BF32 ? 2 : 1)];
  auto gload = [&](int kt) {
    if constexpr (!AHB) {
      const char* ab = abase + (size_t)kt * (BK * 2);
      areg[0] = *reinterpret_cast<const u32x4*>(ab + aoff0);
      if constexpr (C::AP == 2) areg[1] = *reinterpret_cast<const u32x4*>(ab + aoff1);
    }
    const char* bb = bbase + (size_t)kt * BK * ldbB;
#pragma unroll
    for (int i = 0; i < C::BP; ++i) {
      const char* pp = bb + (size_t)(i * C::RSTEP) * ldbB + boff;
      if constexpr (BF32) { breg[2 * i] = *reinterpret_cast<const u32x4*>(pp); breg[2 * i + 1] = *reinterpret_cast<const u32x4*>(pp + 16); }
      else breg[i] = *reinterpret_cast<const u32x4*>(pp);
    }
  };
  auto swrite = [&](int buf) {
    char* s = stage + buf * STG;
    if constexpr (!AHB) {
      *reinterpret_cast<u32x4*>(s + ast0) = areg[0];
      if constexpr (C::AP == 2) *reinterpret_cast<u32x4*>(s + ast1) = areg[1];
    }
#pragma unroll
    for (int i = 0; i < C::BP; ++i) {
      const int bo = ABYTES + b_st_off<BN>(bk0 + i * C::RSTEP, bc);
      if constexpr (BF32) {
        f32x4 lo = *reinterpret_cast<f32x4*>(&breg[2 * i]), hh = *reinterpret_cast<f32x4*>(&breg[2 * i + 1]);
        *reinterpret_cast<bf16x8*>(s + bo) = cvt8(lo, hh);
      } else *reinterpret_cast<u32x4*>(s + bo) = breg[i];
    }
  };
  (void)bst0;
  gload(0);
  swrite(0);
  if (NT > 1) gload(1);
  __syncthreads();
#pragma unroll 1
  for (int kt = 0; kt < NT; ++kt) {
    const int cur = kt & 1;
    if (kt + 1 < NT) swrite(cur ^ 1);
    if (kt + 2 < NT) gload(kt + 2);
    const char* As = stage + cur * STG;
    const int b0 = bb0 + cur * STG, b1 = bb1 + cur * STG;
#define KSTEP(S)                                                                                                   \
    do { bf16x8 a0, a1;                                                                                            \
      if constexpr (AHB) { const int ch = kt * (BK / 8) + (S) * 2 + hi;                                            \
        a0 = *reinterpret_cast<const bf16x8*>(hb + hb_off(row0, ch)); a1 = *reinterpret_cast<const bf16x8*>(hb + hb_off(row1, ch)); } \
      else { a0 = *reinterpret_cast<const bf16x8*>(As + a_off<BK>(row0, (S) * 2 + hi)); a1 = *reinterpret_cast<const bf16x8*>(As + a_off<BK>(row1, (S) * 2 + hi)); } \
      kstep<BN, S, SWAP, DUAL>(acc, a0, a1, b0, b1); } while (0)
    KSTEP(0); KSTEP(1);
    if constexpr (BK == 64) { KSTEP(2); KSTEP(3); }
#undef KSTEP
    __syncthreads();
  }
}

__device__ __forceinline__ unsigned pack_pair(float v0, float v1, int odd) {
  const float send = odd ? v0 : v1;
  const float recv = __shfl_xor(send, 1);
  const float lo = odd ? recv : v0, hh = odd ? v1 : recv;
  return cvtpk(lo, hh);
}

__device__ __forceinline__ void cvt_range(const float* __restrict__ src, bf16_t* __restrict__ dst, size_t n8, size_t gtid, size_t gsz) {
  for (size_t i = gtid; i < n8; i += gsz) {
    const f32x4 a = *reinterpret_cast<const f32x4*>(src + i * 8), b = *reinterpret_cast<const f32x4*>(src + i * 8 + 4);
    *reinterpret_cast<bf16x8*>(dst + i * 8) = cvt8(a, b);
  }
}
__device__ void phase_prologue(const Params& p) {
  const size_t gtid = (size_t)blockIdx.x * NTHR + threadIdx.x, gsz = (size_t)gridDim.x * NTHR;
  char* ws = p.ws;
  if (blockIdx.x == 0) { ((int*)(ws + OFF_CNT))[threadIdx.x] = 0; }
  cvt_range(p.pool_w, (bf16_t*)(ws + OFF_WPOOL), 4 * 256 * 256 / 8, gtid, gsz);
  cvt_range(p.router_w, (bf16_t*)(ws + OFF_WR), 2 * DM * NEXP / 8, gtid, gsz);
  cvt_range(p.w_uq, (bf16_t*)(ws + OFF_WUQ), QL * 1536 / 8, gtid, gsz);
  cvt_range(p.w_uk, (bf16_t*)(ws + OFF_WUK), KVL * 1024 / 8, gtid, gsz);
  cvt_range(p.w_uv, (bf16_t*)(ws + OFF_WUV), KVL * 1024 / 8, gtid, gsz);
  cvt_range(p.w_o, (bf16_t*)(ws + OFF_WO), DM * DM / 8, gtid, gsz);
  cvt_range(p.sw_gate, (bf16_t*)(ws + OFF_SWG), 2 * DM * EFF / 8, gtid, gsz);
  cvt_range(p.sw_up, (bf16_t*)(ws + OFF_SWU), 2 * DM * EFF / 8, gtid, gsz);
  cvt_range(p.sw_down, (bf16_t*)(ws + OFF_SWD), 2 * EFF * DM / 8, gtid, gsz);
  {
    bf16_t* wa = (bf16_t*)(ws + OFF_WA);
    for (size_t i = gtid; i < (size_t)DM * WA_NP / 8; i += gsz) {
      const int k = (int)(i / (WA_NP / 8)), n = (int)(i % (WA_NP / 8)) * 8;
      bf16x8 v = {0, 0, 0, 0, 0, 0, 0, 0};
      if (n < WA_N) { const float* s = p.w_a + (size_t)k * WA_N + n; v = cvt8(*reinterpret_cast<const f32x4*>(s), *reinterpret_cast<const f32x4*>(s + 4)); }
      *reinterpret_cast<bf16x8*>(wa + (size_t)k * WA_NP + n) = v;
    }
  }
  {
    float* rc = (float*)(ws + OFF_ROPE); float* rs = rc + SEQ * 32;
    for (size_t i = gtid; i < (size_t)SEQ * 32; i += gsz) {
      const int pos = (int)(i >> 5), j = (int)(i & 31);
      const double inv = exp(-(double)(2 * j) / 64.0 * 9.210340371976184);
      const double ang = (double)pos * inv;
      rc[i] = (float)cos(ang); rs[i] = (float)sin(ang);
    }
  }
  {
    bf16_t* pooled = (bf16_t*)(ws + OFF_POOLED);
    const int c = threadIdx.x * 2, g = c >> 8, half = 1 << g;
    for (int ch = blockIdx.x; ch < NTOK / 32; ch += gridDim.x) {
      const int t0 = ch * 32, s0 = t0 & (SEQ - 1);
      const float* xb = p.x + (size_t)(t0 - s0) * DM + c;
      f32x2 s = {0.f, 0.f};
      for (int r = s0 - half; r < s0 + half; ++r) if (r >= 0 && r < SEQ) { const f32x2 v = *reinterpret_cast<const f32x2*>(xb + (size_t)r * DM); s += v; }
      for (int i = 0; i < 32; ++i) {
        const int t = s0 + i;
        const int lo = t - half < 0 ? 0 : t - half, hi = t + half > SEQ ? SEQ : t + half;
        const float inv = 1.f / (float)(hi - lo);
        const f32x2 xv = *reinterpret_cast<const f32x2*>(xb + (size_t)t * DM);
        *reinterpret_cast<unsigned*>(pooled + (size_t)(t0 + i) * DM + c) = cvtpk(s[0] * inv - xv[0], s[1] * inv - xv[1]);
        if (t + half < SEQ) s += *reinterpret_cast<const f32x2*>(xb + (size_t)(t + half) * DM);
        if (t - half >= 0) s -= *reinterpret_cast<const f32x2*>(xb + (size_t)(t - half) * DM);
      }
    }
  }
}

constexpr int GBN = 256, GBK = 64;
enum { EPI_POOL = 0, EPI_F32 = 1, EPI_Q = 2, EPI_K = 3, EPI_V = 4, EPI_WO = 5 };

template <int EPI>
__device__ __forceinline__ void dense_tile(const Params& p, char* lds, const bf16_t* A, int lda, const bf16_t* B, int ldb, int K, int m0, int n0,
                                           float* outf, bf16_t* outb, int ldo, int aux) {
  using C = GC<GBN, GBK>;
  int tid = opaque_tid(), lane = tid & 63, wid = tid >> 6, r32 = lane & 31, hi = lane >> 5, wm = wid >> 2, wn = wid & 3;
  f32x16 acc[2][2];
#pragma unroll
  for (int i = 0; i < 2; ++i)
#pragma unroll
    for (int j = 0; j < 2; ++j) acc[i][j] = f32x16{};
  const char* abase = (const char*)(A + (size_t)m0 * lda);
  const unsigned aoff0 = (unsigned)(((tid >> 3) * lda + (tid & 7) * 8) * 2), aoff1 = aoff0 + (unsigned)(64 * lda * 2);
  const int bk0 = tid / C::CPR, bc = (tid % C::CPR) * 8;
  gemm_core<GBN, GBK, false, false, false, bf16_t>(acc, abase, aoff0, aoff1, (const char*)(B + n0), (unsigned)((bk0 * ldb + bc) * 2), (unsigned)(ldb * 2), bk0, bc, K / GBK, lds, nullptr);
  tid = opaque_tid(); lane = tid & 63; wid = tid >> 6; r32 = lane & 31; hi = lane >> 5; wm = wid >> 2; wn = wid & 3;
  const int nb = n0 + wn * 64;
#pragma unroll
  for (int i = 0; i < 2; ++i) {
    const int mb = m0 + wm * 64 + i * 32;
    if constexpr (EPI == EPI_POOL) {
#pragma unroll
      for (int j = 0; j < 2; ++j) {
        const int n = aux * 256 + nb + j * 32 + r32;
        const float bb = p.pool_b[n], sc = p.pool_scale[n];
#pragma unroll
        for (int r = 0; r < 16; ++r) { const size_t o = (size_t)(mb + crow(r, hi)) * DM + n; outf[o] = (acc[i][j][r] + bb) * sc + ALPHA * p.x[o]; }
      }
    } else if constexpr (EPI == EPI_F32) {
#pragma unroll
      for (int j = 0; j < 2; ++j) { const int n = nb + j * 32 + r32;
#pragma unroll
        for (int r = 0; r < 16; ++r) outf[(size_t)(mb + crow(r, hi)) * ldo + n] = acc[i][j][r]; }
    } else if constexpr (EPI == EPI_WO) {
      const float* hres = (const float*)(p.ws + OFF_H1F);
#pragma unroll
      for (int j = 0; j < 2; ++j) { const int n = nb + j * 32 + r32;
#pragma unroll
        for (int r = 0; r < 16; ++r) { const size_t o = (size_t)(mb + crow(r, hi)) * DM + n; outf[o] = acc[i][j][r] + ALPHA * hres[o]; } }
    } else {
      const int cb64 = nb >> 6;
      int colbase; bool rope = false;
      if constexpr (EPI == EPI_Q) { colbase = nb; rope = (cb64 % 3) == 2; }
      else if constexpr (EPI == EPI_K) { colbase = (nb >> 7) * 192 + (nb & 127); }
      else colbase = nb;
      const int odd = lane & 1;
      if (rope) {
        const float* rc = (const float*)(p.ws + OFF_ROPE); const float* rs = rc + SEQ * 32;
#pragma unroll
        for (int r = 0; r < 16; ++r) {
          const int pos = (mb + crow(r, hi)) & (SEQ - 1);
          const float c = rc[pos * 32 + r32], s = rs[pos * 32 + r32];
          const float x1 = acc[i][0][r], x2 = acc[i][1][r];
          acc[i][0][r] = x1 * c - x2 * s; acc[i][1][r] = x1 * s + x2 * c;
        }
      }
#pragma unroll
      for (int j = 0; j < 2; ++j) {
#pragma unroll
        for (int r = 0; r < 16; r += 2) {
          const unsigned pk = pack_pair(acc[i][j][r], acc[i][j][r + 1], odd);
          const int row = mb + crow(r, hi) + odd;
          const int col = colbase + j * 32 + (r32 & ~1);
          *reinterpret_cast<unsigned*>(outb + (size_t)row * ldo + col) = pk;
        }
      }
    }
  }
}

__device__ void phase_pool_gemm(const Params& p, char* lds) {
  const bf16_t* pooled = (const bf16_t*)(p.ws + OFF_POOLED); const bf16_t* wp = (const bf16_t*)(p.ws + OFF_WPOOL);
  float* z = (float*)(p.ws + OFF_Z);
  for (int u = blockIdx.x; u < 128 * 4; u += gridDim.x) {
    const int mt = u >> 2, g = u & 3;
    dense_tile<EPI_POOL>(p, lds, pooled + g * 256, DM, wp + (size_t)g * 65536, 256, 256, mt * 128, 0, z, nullptr, DM, g);
  }
}
__device__ void phase_router_gemm(const Params& p, char* lds, int layer) {
  const bf16_t* hb = (const bf16_t*)(p.ws + (layer == 0 ? OFF_H0B : OFF_H0B));
  const bf16_t* wr = (const bf16_t*)(p.ws + OFF_WR) + (size_t)layer * DM * NEXP;
  float* lg = (float*)(p.ws + OFF_LOGIT);
  for (int u = blockIdx.x; u < 128; u += gridDim.x) dense_tile<EPI_F32>(p, lds, hb, DM, wr, NEXP, DM, u * 128, 0, lg, nullptr, NEXP, 0);
}
__device__ void phase_wa_gemm(const Params& p, char* lds) {
  const bf16_t* hb = (const bf16_t*)(p.ws + OFF_H1B); const bf16_t* wa = (const bf16_t*)(p.ws + OFF_WA);
  float* ab = (float*)(p.ws + OFF_ABUF);
  for (int u = blockIdx.x; u < 128 * 3; u += gridDim.x) { const int mt = u / 3, nt = u % 3;
    dense_tile<EPI_F32>(p, lds, hb, DM, wa, WA_NP, DM, mt * 128, nt * 256, ab, nullptr, WA_NP, 0); }
}
__device__ void phase_qkv_gemm(const Params& p, char* lds) {
  const bf16_t* ql = (const bf16_t*)(p.ws + OFF_QLAT); const bf16_t* kvl = (const bf16_t*)(p.ws + OFF_KVLAT);
  const bf16_t* wuq = (const bf16_t*)(p.ws + OFF_WUQ); const bf16_t* wuk = (const bf16_t*)(p.ws + OFF_WUK); const bf16_t* wuv = (const bf16_t*)(p.ws + OFF_WUV);
  bf16_t* Q = (bf16_t*)(p.ws + OFF_Q); bf16_t* Kb = (bf16_t*)(p.ws + OFF_K); bf16_t* V = (bf16_t*)(p.ws + OFF_V);
  for (int u = blockIdx.x; u < 128 * 14; u += gridDim.x) {
    const int mt = u / 14, s = u % 14;
    if (s < 6) dense_tile<EPI_Q>(p, lds, ql, QL, wuq, 1536, QL, mt * 128, s * 256, nullptr, Q, 1536, 0);
    else if (s < 10) dense_tile<EPI_K>(p, lds, kvl, KVL, wuk, 1024, KVL, mt * 128, (s - 6) * 256, nullptr, Kb, 1536, 0);
    else dense_tile<EPI_V>(p, lds, kvl, KVL, wuv, 1024, KVL, mt * 128, (s - 10) * 256, nullptr, V, 1024, 0);
  }
}
__device__ void phase_wo_gemm(const Params& p, char* lds) {
  const bf16_t* O = (const bf16_t*)(p.ws + OFF_O); const bf16_t* wo = (const bf16_t*)(p.ws + OFF_WO);
  float* z = (float*)(p.ws + OFF_Z);
  for (int u = blockIdx.x; u < 128 * 4; u += gridDim.x) { const int mt = u >> 2, nt = u & 3;
    dense_tile<EPI_WO>(p, lds, O, DM, wo, DM, DM, mt * 128, nt * 256, z, nullptr, DM, 0); }
}

__device__ __forceinline__ void ln_row_store(f32x4 (&v)[4], const float* g, const float* b, float* of, bf16_t* ob, int lane) {
  float s = 0.f;
#pragma unroll
  for (int i = 0; i < 4; ++i) s += v[i][0] + v[i][1] + v[i][2] + v[i][3];
  const float mu = wave_sum(s) * (1.f / DM);
  float q = 0.f;
#pragma unroll
  for (int i = 0; i < 4; ++i) { v[i] -= mu; q += v[i][0] * v[i][0] + v[i][1] * v[i][1] + v[i][2] * v[i][2] + v[i][3] * v[i][3]; }
  const float rstd = rsqrtf(wave_sum(q) * (1.f / DM) + LN_EPS);
#pragma unroll
  for (int i = 0; i < 4; ++i) {
    const int c = lane * 4 + 256 * i;
    const f32x4 gg = *reinterpret_cast<const f32x4*>(g + c), bb = *reinterpret_cast<const f32x4*>(b + c);
    const f32x4 o = v[i] * rstd * gg + bb;
    *reinterpret_cast<f32x4*>(of + c) = o;
    if (ob) { u32x2 w = {cvtpk(o[0], o[1]), cvtpk(o[2], o[3])}; *reinterpret_cast<u32x2*>(ob + c) = w; }
  }
}
__device__ void phase_ln(const Params& p, const float* g, const float* b, float* of, bf16_t* ob) {
  const float* z = (const float*)(p.ws + OFF_Z);
  const int lane = threadIdx.x & 63, wv = blockIdx.x * 8 + (threadIdx.x >> 6);
  for (int t = wv; t < NTOK; t += gridDim.x * 8) {
    f32x4 v[4];
#pragma unroll
    for (int i = 0; i < 4; ++i) v[i] = *reinterpret_cast<const f32x4*>(z + (size_t)t * DM + lane * 4 + 256 * i);
    ln_row_store(v, g, b, of + (size_t)t * DM, ob ? ob + (size_t)t * DM : nullptr, lane);
  }
}
__device__ void phase_combine_ln(const Params& p, const float* hres, const float* g, const float* b, float* of, bf16_t* ob) {
  const bf16_t* Y = (const bf16_t*)(p.ws + OFF_Y); const bf16_t* Ysh = (const bf16_t*)(p.ws + OFF_YSH);
  const int lane = threadIdx.x & 63, wv = blockIdx.x * 8 + (threadIdx.x >> 6);
  for (int t = wv; t < NTOK; t += gridDim.x * 8) {
    f32x4 v[4];
#pragma unroll
    for (int i = 0; i < 4; ++i) {
      const int c = lane * 4 + 256 * i;
      v[i] = *reinterpret_cast<const f32x4*>(hres + (size_t)t * DM + c) * ALPHA;
      u32x2 w = *reinterpret_cast<const u32x2*>(Ysh + (size_t)t * DM + c);
      v[i][0] += __uint_as_float(w[0] << 16); v[i][1] += __uint_as_float(w[0] & 0xffff0000u);
      v[i][2] += __uint_as_float(w[1] << 16); v[i][3] += __uint_as_float(w[1] & 0xffff0000u);
#pragma unroll
      for (int k = 0; k < TOPK; ++k) {
        w = *reinterpret_cast<const u32x2*>(Y + ((size_t)t * TOPK + k) * DM + c);
        v[i][0] += __uint_as_float(w[0] << 16); v[i][1] += __uint_as_float(w[0] & 0xffff0000u);
        v[i][2] += __uint_as_float(w[1] << 16); v[i][3] += __uint_as_float(w[1] & 0xffff0000u);
      }
    }
    ln_row_store(v, g, b, of + (size_t)t * DM, ob ? ob + (size_t)t * DM : nullptr, lane);
  }
}

__device__ void phase_route(const Params& p, int layer) {
  const float* lg = (const float*)(p.ws + OFF_LOGIT);
  const float* rb = p.router_b + layer * NEXP;
  int* cnt = (int*)(p.ws + OFF_CNT) + layer * NEXP;
  int* list = (int*)(p.ws + OFF_LIST);
  float* gate = (float*)(p.ws + OFF_GATE);
  int* texp = (int*)(p.ws + OFF_TEXP);
  const int lane = threadIdx.x & 63, wv = blockIdx.x * 8 + (threadIdx.x >> 6);
  const f32x4 bias = *reinterpret_cast<const f32x4*>(rb + lane * 4);
  for (int t = wv; t < NTOK; t += gridDim.x * 8) {
    const f32x4 z = *reinterpret_cast<const f32x4*>(lg + (size_t)t * NEXP + lane * 4);
    float sc[4], bv[4];
#pragma unroll
    for (int k = 0; k < 4; ++k) { sc[k] = 1.f / (1.f + __expf(-z[k])); bv[k] = sc[k] + bias[k]; }
    float m1 = fmaxf(bv[0], bv[1]), m2 = fminf(bv[0], bv[1]);
#pragma unroll
    for (int k = 2; k < 4; ++k) { const float a = bv[k]; const float n1 = fmaxf(m1, a); m2 = fmaxf(fminf(m1, a), m2); m1 = n1; }
#pragma unroll
    for (int o = 1; o < 8; o <<= 1) {
      const float o1 = __shfl_xor(m1, o), o2 = __shfl_xor(m2, o);
      const float n1 = fmaxf(m1, o1); m2 = fmaxf(fminf(m1, o1), fmaxf(m2, o2)); m1 = n1;
    }
    const float gs = m1 + m2; const int grp = lane >> 3;
    int rank = 0;
#pragma unroll
    for (int g2 = 0; g2 < 8; ++g2) { const float og = __shfl(gs, g2 * 8); rank += (og > gs || (og == gs && g2 < grp)) ? 1 : 0; }
    const bool sel = rank < 4;
#pragma unroll
    for (int k = 0; k < 4; ++k) if (!sel) bv[k] = -INFINITY;
    int my_e = 0; float my_s = 0.f, ssum = 0.f;
#pragma unroll 1
    for (int kk = 0; kk < TOPK; ++kk) {
      float lb = bv[0]; int li = 0;
#pragma unroll
      for (int k = 1; k < 4; ++k) if (bv[k] > lb) { lb = bv[k]; li = k; }
      const float mx = wave_max(lb);
      const unsigned long long bal = __ballot(lb == mx);
      const int wl = __ffsll((long long)bal) - 1;
      const int we = __shfl(lane * 4 + li, wl);
      float ws_ = sc[0];
#pragma unroll
      for (int k = 1; k < 4; ++k) if (li == k) ws_ = sc[k];
      ws_ = __shfl(ws_, wl);
      if (lane == wl) {
#pragma unroll
        for (int k = 0; k < 4; ++k) if (li == k) bv[k] = -INFINITY;
      }
      ssum += ws_;
      if (lane == kk) { my_e = we; my_s = ws_; }
    }
    if (lane < TOPK) {
      const int pos = atomicAdd(&cnt[my_e], 1);
      list[(size_t)my_e * NTOK + pos] = t * TOPK + lane;
      gate[t * TOPK + lane] = my_s / ssum * 2.5f;
      texp[t * TOPK + lane] = my_e;
    }
  }
}

__device__ void phase_mla_rows(const Params& p) {
  const float* ab = (const float*)(p.ws + OFF_ABUF);
  bf16_t* ql = (bf16_t*)(p.ws + OFF_QLAT); bf16_t* kvl = (bf16_t*)(p.ws + OFF_KVLAT); bf16_t* Kb = (bf16_t*)(p.ws + OFF_K);
  const float* rc = (const float*)(p.ws + OFF_ROPE); const float* rs = rc + SEQ * 32;
  const int lane = threadIdx.x & 63, wv = blockIdx.x * 8 + (threadIdx.x >> 6);
  for (int t = wv; t < NTOK; t += gridDim.x * 8) {
    const float* a = ab + (size_t)t * WA_NP;
    float q[6], kv[4];
    float sq = 0.f, sk = 0.f;
#pragma unroll
    for (int i = 0; i < 6; ++i) { q[i] = a[lane + 64 * i]; sq += q[i] * q[i]; }
#pragma unroll
    for (int i = 0; i < 4; ++i) { kv[i] = a[QL + lane + 64 * i]; sk += kv[i] * kv[i]; }
    const float rq = rsqrtf(wave_sum(sq) * (1.f / QL) + RMS_EPS), rk = rsqrtf(wave_sum(sk) * (1.f / KVL) + RMS_EPS);
#pragma unroll
    for (int i = 0; i < 6; ++i) ql[(size_t)t * QL + lane + 64 * i] = f2bf(q[i] * rq * p.qn_g[lane + 64 * i]);
#pragma unroll
    for (int i = 0; i < 4; ++i) kvl[(size_t)t * KVL + lane + 64 * i] = f2bf(kv[i] * rk * p.kvn_g[lane + 64 * i]);
    const float mine = a[QL + KVL + lane];
    const float other = __shfl_xor(mine, 32);
    const int pos = t & (SEQ - 1), j = lane & 31;
    const float c = rc[pos * 32 + j], s = rs[pos * 32 + j];
    const float o = lane < 32 ? mine * c - other * s : other * s + mine * c;
    const bf16_t ob = f2bf(o);
#pragma unroll
    for (int h = 0; h < NH; ++h) Kb[(size_t)t * 1536 + h * DQK + DNOPE + lane] = ob;
  }
}

constexpr int MOE_STAGE = 2 * GC<512, 32>::STAGE;
constexpr int MOE_HB = MOE_STAGE;
constexpr int MOE_META = MOE_HB + 65536;
constexpr int LDS_BYTES = MOE_META + 128 * 4 + 128 * 4 + 260 * 4;
static_assert(LDS_BYTES <= 160 * 1024, "LDS");

__device__ void phase_moe(const Params& p, char* lds, int layer) {
  using C = GC<512, 32>;
  int tid = threadIdx.x, lane = tid & 63, wid = tid >> 6, r32 = lane & 31, hi = lane >> 5, wm = wid >> 2, wn = wid & 3;
  const int* cnt = (const int*)(p.ws + OFF_CNT) + layer * NEXP;
  const int* list = (const int*)(p.ws + OFF_LIST);
  const float* gatev = (const float*)(p.ws + OFF_GATE);
  const bf16_t* hin = (const bf16_t*)(p.ws + (layer == 0 ? OFF_H0B : OFF_H0B));
  bf16_t* Y = (bf16_t*)(p.ws + OFF_Y); bf16_t* Ysh = (bf16_t*)(p.ws + OFF_YSH);
  int* s_slot = (int*)(lds + MOE_META); float* s_gate = (float*)(lds + MOE_META + 512); int* s_pre = (int*)(lds + MOE_META + 1024);
  char* hb = lds + MOE_HB;
  if (tid < 64) {
    int run = 0;
    for (int c0 = 0; c0 < 256; c0 += 64) {
      const int e = c0 + tid; const int tl = (cnt[e] + 127) >> 7;
      int incl = tl;
#pragma unroll
      for (int o = 1; o < 64; o <<= 1) { const int v = __shfl_up(incl, o); if (lane >= o) incl += v; }
      s_pre[e] = run + incl - tl;
      run += __shfl(incl, 63);
    }
    if (tid == 0) { s_pre[256] = run; s_pre[257] = run + 128; }
  }
  __syncthreads();
  const int U = s_pre[257];
  const int G = gridDim.x, xg = blockIdx.x & 7, rk = blockIdx.x >> 3, ng = (G + 7 - xg) >> 3;
  const int ustart = (int)((long long)U * xg / 8), uend = (int)((long long)U * (xg + 1) / 8);
  for (int u = ustart + rk; u < uend; u += ng) {
    int lo = 0, hi_ = 256;
    while (lo < hi_) { const int mid = (lo + hi_ + 1) >> 1; if (s_pre[mid] <= u) lo = mid; else hi_ = mid - 1; }
    const int e = lo, tile = u - s_pre[e];
    const bool shared = e == 256;
    __syncthreads();
    tid = opaque_tid(); lane = tid & 63; wid = tid >> 6; r32 = lane & 31; hi = lane >> 5; wm = wid >> 2; wn = wid & 3;
    if (tid < 128) {
      int slot = -1; float gt = 0.f;
      if (shared) { slot = tile * 128 + tid; gt = 1.f; }
      else { const int idx = tile * 128 + tid; if (idx < cnt[e]) { slot = list[(size_t)e * NTOK + idx]; gt = gatev[slot]; } }
      s_slot[tid] = slot; s_gate[tid] = gt;
    }
    __syncthreads();
    const float *wg, *wu, *wd;
    if (shared) { wg = p.sw_gate + (size_t)layer * DM * EFF; wu = p.sw_up + (size_t)layer * DM * EFF; wd = p.sw_down + (size_t)layer * EFF * DM; }
    else { const size_t eo = (size_t)layer * NEXP + e; wg = p.ew_gate + eo * DM * EFF; wu = p.ew_up + eo * DM * EFF; wd = p.ew_down + eo * EFF * DM; }
    f32x16 acc[2][4];
#pragma unroll
    for (int i = 0; i < 2; ++i)
#pragma unroll
      for (int j = 0; j < 4; ++j) acc[i][j] = f32x16{};
    {
      const int sl = s_slot[tid >> 2];
      const int tok = sl < 0 ? 0 : (shared ? sl : (sl >> 3));
      const unsigned aoff = (unsigned)(tok * (DM * 2) + (tid & 3) * 16);
      const int arr = __builtin_amdgcn_readfirstlane(wid) & 1, bk0 = (wid >> 1) * 2 + ((tid >> 5) & 1), cl = (tid & 31) * 8;
      const char* bbase = (const char*)(arr ? wu : wg);
      gemm_core<512, 32, true, false, true, float>(acc, (const char*)hin, aoff, aoff, bbase, (unsigned)((bk0 * EFF + cl) * 4), (unsigned)(EFF * 4), bk0, arr * 256 + cl, DM / 32, lds, nullptr);
    }
    tid = opaque_tid(); lane = tid & 63; wid = tid >> 6; r32 = lane & 31; hi = lane >> 5; wm = wid >> 2; wn = wid & 3;
#pragma unroll
    for (int i = 0; i < 2; ++i) {
      const int m = wm * 64 + i * 32 + r32;
#pragma unroll
      for (int j = 0; j < 2; ++j) {
#pragma unroll
        for (int q = 0; q < 4; ++q) {
          float hv[4];
#pragma unroll
          for (int e2 = 0; e2 < 4; ++e2) { const float g = acc[i][j][4 * q + e2], uu = acc[i][j + 2][4 * q + e2]; hv[e2] = g * __builtin_amdgcn_rcpf(1.f + __expf(-g)) * uu; }
          const int chunk = 8 * wn + 4 * j + q;
          u32x2 w = {cvtpk(hv[0], hv[1]), cvtpk(hv[2], hv[3])};
          *reinterpret_cast<u32x2*>(hb + hb_off(m, chunk) + 8 * hi) = w;
        }
      }
    }
    __syncthreads();
    bf16_t* Yo = shared ? Ysh : Y;
#pragma unroll 1
    for (int pz = 0; pz < 2; ++pz) {
#pragma unroll
      for (int i = 0; i < 2; ++i)
#pragma unroll
        for (int j = 0; j < 4; ++j) acc[i][j] = f32x16{};
      {
        const int c8 = tid & 63, bk0 = tid >> 6;
        gemm_core<512, 32, false, true, false, float>(acc, nullptr, 0u, 0u, (const char*)(wd + pz * 512), (unsigned)((bk0 * DM + c8 * 8) * 4), (unsigned)(DM * 4), bk0, c8 * 8, EFF / 32, lds, hb);
      }
      tid = opaque_tid(); lane = tid & 63; wid = tid >> 6; r32 = lane & 31; hi = lane >> 5; wm = wid >> 2; wn = wid & 3;
      const int odd = lane & 1;
#pragma unroll
      for (int i = 0; i < 2; ++i) {
#pragma unroll
        for (int r = 0; r < 16; r += 2) {
          const int ml = wm * 64 + i * 32 + crow(r, hi);
          const float g0 = s_gate[ml], g1 = s_gate[ml + 1];
          const int slot = s_slot[ml + odd];
          bf16_t* yrow = Yo + (size_t)(slot < 0 ? 0 : slot) * DM + pz * 512 + wn * 128 + (r32 & ~1);
#pragma unroll
          for (int j = 0; j < 4; ++j) {
            const unsigned pk = pack_pair(acc[i][j][r] * g0, acc[i][j][r + 1] * g1, odd);
            if (slot >= 0) *reinterpret_cast<unsigned*>(yrow + j * 32) = pk;
          }
        }
      }
    }
  }
}

namespace at {
constexpr int KVBLK = 64;
constexpr float SCALE = 0.07216878364870323f;
constexpr float THR = 8.f;
constexpr int LDQ = 1536, LDK = 1536, LDV = 1024, LDO = 1024;
constexpr int SHM_V = 16384, SHM_KN = 16384, SHM_KR = 8192;
constexpr int OFF_KN = 2 * SHM_V, OFF_KR = OFF_KN + 2 * SHM_KN, OFF_WS = OFF_KR + 2 * SHM_KR, OFF_QR = OFF_WS + 8 * 64 * 4;
#define KSWZ(row, colB) ((row) * 256 + ((colB) ^ (((row) & 7) << 4)))
#define KRSWZ(row, colB) ((row) * 128 + ((colB) ^ ((((row) >> 1) & 7) << 4)))

__device__ __forceinline__ void partialSM(f32x16& p0, f32x16& p1, float& m_reg, float& mn, float& alpha) {
  constexpr float C = SCALE * 1.4426950408889634f;
  float pmax = p0[0];
#pragma unroll
  for (int r = 1; r < 16; ++r) pmax = fmaxf(pmax, p0[r]);
#pragma unroll
  for (int r = 0; r < 16; ++r) pmax = fmaxf(pmax, p1[r]);
  { auto rr = __builtin_amdgcn_permlane32_swap(__float_as_uint(pmax), __float_as_uint(pmax), false, false);
    pmax = fmaxf(__uint_as_float(rr[0]), __uint_as_float(rr[1])); }
  if (__builtin_expect(__all(pmax - m_reg <= THR / SCALE), 1)) { mn = m_reg; alpha = 1.f; }
  else { mn = fmaxf(m_reg, pmax); alpha = __builtin_amdgcn_exp2f((m_reg - mn) * C); m_reg = mn; }
  const float mnC = -mn * C;
#pragma unroll
  for (int r = 0; r < 16; ++r) p0[r] = fmaf(p0[r], C, mnC);
#pragma unroll
  for (int r = 0; r < 16; ++r) p1[r] = fmaf(p1[r], C, mnC);
#pragma unroll
  for (int r = 0; r < 16; ++r) p0[r] = __builtin_amdgcn_exp2f(p0[r]);
}
__device__ __forceinline__ void finishSM(f32x16& p0, f32x16& p1, float alpha, float& l_reg, bf16x8& pa0, bf16x8& pa1, bf16x8& pa2, bf16x8& pa3) {
#pragma unroll
  for (int r = 0; r < 16; ++r) p1[r] = __builtin_amdgcn_exp2f(p1[r]);
  float ps = 0;
#pragma unroll
  for (int r = 0; r < 16; ++r) ps += p0[r];
#pragma unroll
  for (int r = 0; r < 16; ++r) ps += p1[r];
  { auto rr = __builtin_amdgcn_permlane32_swap(__float_as_uint(ps), __float_as_uint(ps), false, false);
    ps = __uint_as_float(rr[0]) + __uint_as_float(rr[1]); }
  l_reg = l_reg * alpha + ps;
#define PK4(P, BASE, OUT) do { unsigned a0 = cvtpk(P[BASE + 0], P[BASE + 1]), a1 = cvtpk(P[BASE + 2], P[BASE + 3]);   \
    unsigned b0 = cvtpk(P[BASE + 4], P[BASE + 5]), b1 = cvtpk(P[BASE + 6], P[BASE + 7]);                              \
    auto r0 = __builtin_amdgcn_permlane32_swap(a0, b0, false, false); auto r1 = __builtin_amdgcn_permlane32_swap(a1, b1, false, false); \
    u32x4 w = {r0[0], r1[0], r0[1], r1[1]}; OUT = *reinterpret_cast<bf16x8*>(&w); } while (0)
  PK4(p0, 0, pa0); PK4(p0, 8, pa1); PK4(p1, 0, pa2); PK4(p1, 8, pa3);
#undef PK4
}
__device__ __forceinline__ void qkt(f32x16& p0, f32x16& p1, const char* Kn, const char* Kr, const bf16x8* qr, const char* qrl, int r32, int hi) {
  p0 = f32x16{}; p1 = f32x16{};
#pragma unroll
  for (int d0 = 0; d0 < 8; ++d0) { const int cb = (d0 * 16 + hi * 8) * 2;
    const bf16x8 b0 = *reinterpret_cast<const bf16x8*>(Kn + KSWZ(r32, cb));
    const bf16x8 b1 = *reinterpret_cast<const bf16x8*>(Kn + KSWZ(32 + r32, cb));
    p0 = __builtin_amdgcn_mfma_f32_32x32x16_bf16(b0, qr[d0], p0, 0, 0, 0);
    p1 = __builtin_amdgcn_mfma_f32_32x32x16_bf16(b1, qr[d0], p1, 0, 0, 0); }
#pragma unroll
  for (int d0 = 0; d0 < 4; ++d0) { const int cb = (d0 * 16 + hi * 8) * 2;
    const bf16x8 b0 = *reinterpret_cast<const bf16x8*>(Kr + KRSWZ(r32, cb));
    const bf16x8 b1 = *reinterpret_cast<const bf16x8*>(Kr + KRSWZ(32 + r32, cb));
    const bf16x8 qv = *reinterpret_cast<const bf16x8*>(qrl + d0 * 8192);
    p0 = __builtin_amdgcn_mfma_f32_32x32x16_bf16(b0, qv, p0, 0, 0, 0);
    p1 = __builtin_amdgcn_mfma_f32_32x32x16_bf16(b1, qv, p1, 0, 0, 0); }
}
__device__ __forceinline__ int v_st(int k, int c) { const int kk = (k & ~0xC) | ((k & 4) << 1) | ((k & 8) >> 1); return ((kk >> 3) * 4 + (c >> 5)) * 512 + ((kk & 7) * 32 + (c & 31)) * 2; }
constexpr int v_rd_off(int d0, int ks, int half) { return d0 * 512 + ks * 4096 + half * 2048; }
template <int D0> __device__ __forceinline__ void pv_one(f32x16& od, int vb, bf16x8 pa0, bf16x8 pa1, bf16x8 pa2, bf16x8 pa3) {
  const s16x4 l0 = tr_read<v_rd_off(D0, 0, 0)>(vb), h0 = tr_read<v_rd_off(D0, 0, 1)>(vb), l1 = tr_read<v_rd_off(D0, 1, 0)>(vb), h1 = tr_read<v_rd_off(D0, 1, 1)>(vb);
  const s16x4 l2 = tr_read<v_rd_off(D0, 2, 0)>(vb), h2 = tr_read<v_rd_off(D0, 2, 1)>(vb), l3 = tr_read<v_rd_off(D0, 3, 0)>(vb), h3 = tr_read<v_rd_off(D0, 3, 1)>(vb);
  asm volatile("s_waitcnt lgkmcnt(0)" ::: "memory"); SBAR();
  od = __builtin_amdgcn_mfma_f32_32x32x16_bf16(pa0, PKF(l0, h0), od, 0, 0, 0);
  od = __builtin_amdgcn_mfma_f32_32x32x16_bf16(pa1, PKF(l1, h1), od, 0, 0, 0);
  od = __builtin_amdgcn_mfma_f32_32x32x16_bf16(pa2, PKF(l2, h2), od, 0, 0, 0);
  od = __builtin_amdgcn_mfma_f32_32x32x16_bf16(pa3, PKF(l3, h3), od, 0, 0, 0);
}
__device__ __forceinline__ void pv_d0(f32x16* o, int vb, bf16x8 pa0, bf16x8 pa1, bf16x8 pa2, bf16x8 pa3) {
  pv_one<0>(o[0], vb, pa0, pa1, pa2, pa3); pv_one<1>(o[1], vb, pa0, pa1, pa2, pa3); pv_one<2>(o[2], vb, pa0, pa1, pa2, pa3); pv_one<3>(o[3], vb, pa0, pa1, pa2, pa3);
}

__device__ __forceinline__ void attn_body(const bf16_t* __restrict__ Qb, const bf16_t* __restrict__ Kh, const bf16_t* __restrict__ Vh,
                                          bf16_t* __restrict__ Ob, int seq, char* lds) {
  const int tid = opaque_tid(), wid = tid >> 6, lane = tid & 63, r32 = lane & 31, hi = lane >> 5;
  char* V_lds = lds; char* KN_lds = lds + OFF_KN; char* KR_lds = lds + OFF_KR;
  float* ws = (float*)(lds + OFF_WS) + wid * 64; float* li_l = ws; float* al_l = ws + 32;
  float m_reg = -1e30f, l_reg = 0; f32x16 o[4] = {}; bf16x8 qr[8];
  char* qrl = lds + OFF_QR + tid * 16;
  {
    const char* Qc = (const char*)Qb; const unsigned qoff = (unsigned)(((wid * 32 + r32) * LDQ + hi * 8) * 2);
#pragma unroll
    for (int d0 = 0; d0 < 8; ++d0) qr[d0] = *reinterpret_cast<const bf16x8*>(Qc + qoff + d0 * 32);
#pragma unroll
    for (int d0 = 0; d0 < 4; ++d0) *reinterpret_cast<bf16x8*>(qrl + d0 * 8192) = *reinterpret_cast<const bf16x8*>(Qc + qoff + (8 + d0) * 32);
  }
  const int sr = tid >> 4, sc = (tid & 15) * 8, vst0 = v_st(sr, sc), vst1 = v_st(32 + sr, sc);
  const int krr = tid >> 3, krc = (tid & 7) * 8;
  const int vb0 = (int)(uintptr_t)V_lds + v_rd_base(lane);
  const unsigned voff0 = (unsigned)((sr * LDV + sc) * 2), voff1 = voff0 + 32 * LDV * 2;
  const unsigned koff0 = (unsigned)((sr * LDK + sc) * 2), koff1 = koff0 + 32 * LDK * 2, koffr = (unsigned)((krr * LDK + DNOPE + krc) * 2);
  const char* Vc = (const char*)Vh; const char* Kc = (const char*)Kh;
  bf16x8 s_vs0, s_vs1, s_ks0, s_ks1, s_kr;
#define SLOAD(k0) do { const char* vt = Vc + (size_t)(k0) * (LDV * 2); const char* kt_ = Kc + (size_t)(k0) * (LDK * 2);                    \
    s_vs0 = *reinterpret_cast<const bf16x8*>(vt + voff0); s_vs1 = *reinterpret_cast<const bf16x8*>(vt + voff1);                          \
    s_ks0 = *reinterpret_cast<const bf16x8*>(kt_ + koff0); s_ks1 = *reinterpret_cast<const bf16x8*>(kt_ + koff1);                        \
    s_kr = *reinterpret_cast<const bf16x8*>(kt_ + koffr); } while (0)
#define SWRITE(b) do { *(bf16x8*)(V_lds + (b) * SHM_V + vst0) = s_vs0; *(bf16x8*)(V_lds + (b) * SHM_V + vst1) = s_vs1; const int kc = sc * 2; \
    *(bf16x8*)(KN_lds + (b) * SHM_KN + KSWZ(sr, kc)) = s_ks0; *(bf16x8*)(KN_lds + (b) * SHM_KN + KSWZ(32 + sr, kc)) = s_ks1;   \
    *(bf16x8*)(KR_lds + (b) * SHM_KR + KRSWZ(krr, krc * 2)) = s_kr; } while (0)
#define SWAIT() asm volatile("s_waitcnt vmcnt(0)" ::: "memory")
#define RESC(a) do { if (__any((a) < 1.f)) { if (hi == 0) al_l[r32] = (a); asm volatile("s_waitcnt lgkmcnt(0)" ::: "memory"); \
    for (int d = 0; d < 4; ++d) for (int r = 0; r < 16; ++r) o[d][r] *= al_l[crow(r, hi)]; } } while (0)
  f32x16 pA0, pA1, pB0, pB1; float mnA, mnB, alA, alB; bf16x8 pa0, pa1, pa2, pa3; const int NT = seq / KVBLK;
  SLOAD(0); SWAIT(); SWRITE(0); __syncthreads();
  qkt(pA0, pA1, KN_lds, KR_lds, qr, qrl, r32, hi); partialSM(pA0, pA1, m_reg, mnA, alA);
  SLOAD(KVBLK);
  SWAIT(); SWRITE(1); __syncthreads();
#pragma unroll 1
  for (int j = 1; j + 1 < NT; j += 2) {
    SBAR(); qkt(pB0, pB1, KN_lds + SHM_KN, KR_lds + SHM_KR, qr, qrl, r32, hi);
    finishSM(pA0, pA1, alA, l_reg, pa0, pa1, pa2, pa3); SBAR();
    SLOAD((j + 1) * KVBLK); SBAR();
    pv_d0(o, vb0, pa0, pa1, pa2, pa3); partialSM(pB0, pB1, m_reg, mnB, alB);
    __syncthreads(); SWAIT(); SWRITE(0);
    RESC(alB); __syncthreads();
    SBAR(); qkt(pA0, pA1, KN_lds, KR_lds, qr, qrl, r32, hi);
    finishSM(pB0, pB1, alB, l_reg, pa0, pa1, pa2, pa3); SBAR();
    SLOAD((j + 2) * KVBLK); SBAR();
    pv_d0(o, vb0 + SHM_V, pa0, pa1, pa2, pa3); partialSM(pA0, pA1, m_reg, mnA, alA);
    __syncthreads(); SWAIT(); SWRITE(1);
    RESC(alA); __syncthreads();
  }
  SBAR(); qkt(pB0, pB1, KN_lds + SHM_KN, KR_lds + SHM_KR, qr, qrl, r32, hi);
  finishSM(pA0, pA1, alA, l_reg, pa0, pa1, pa2, pa3); SBAR();
  pv_d0(o, vb0, pa0, pa1, pa2, pa3); partialSM(pB0, pB1, m_reg, mnB, alB);
  __syncthreads(); RESC(alB);
  finishSM(pB0, pB1, alB, l_reg, pa0, pa1, pa2, pa3); SBAR();
  pv_d0(o, vb0 + SHM_V, pa0, pa1, pa2, pa3);
  if (hi == 0) li_l[r32] = l_reg; asm volatile("s_waitcnt lgkmcnt(0)" ::: "memory");
  float rli[16];
#pragma unroll
  for (int r = 0; r < 16; ++r) rli[r] = __builtin_amdgcn_rcpf(li_l[crow(r, hi)]);
  char* Oc = (char*)Ob;
  const int tid2 = opaque_tid(), lane2 = tid2 & 63, odd = lane2 & 1, hi2 = lane2 >> 5;
#pragma unroll
  for (int r = 0; r < 16; r += 2) {
    const unsigned ooff = (unsigned)((((tid2 >> 6) * 32 + crow(r, hi2) + odd) * LDO + (lane2 & 30)) * 2);
#pragma unroll
    for (int d0 = 0; d0 < 4; ++d0) {
      const unsigned pk = pack_pair(o[d0][r] * rli[r], o[d0][r + 1] * rli[r + 1], odd);
      *reinterpret_cast<unsigned*>(Oc + ooff + d0 * 64) = pk;
    }
  }
#undef SLOAD
#undef SWRITE
#undef SWAIT
#undef RESC
}
}

__device__ void phase_attn(const Params& p, char* lds) {
  const bf16_t* Q = (const bf16_t*)(p.ws + OFF_Q); const bf16_t* Kb = (const bf16_t*)(p.ws + OFF_K); const bf16_t* V = (const bf16_t*)(p.ws + OFF_V);
  bf16_t* O = (bf16_t*)(p.ws + OFF_O);
  const int G = gridDim.x, xg = blockIdx.x & 7, rk = blockIdx.x >> 3, ng = (G + 7 - xg) >> 3;
  for (int u = rk; u < 64; u += ng) {
    const int pair = xg + 8 * (u >> 5), qb = u & 31;
    const int b = pair >> 3, h = pair & 7;
    const size_t t0 = (size_t)b * SEQ;
    __syncthreads();
    at::attn_body(Q + (t0 + qb * 256) * 1536 + h * DQK, Kb + t0 * 1536 + h * DQK, V + t0 * 1024 + h * DVH, O + (t0 + qb * 256) * 1024 + h * DVH, SEQ, lds);
  }
}

constexpr int NPHASE = 17;
template <int PH> __device__ __forceinline__ void run_phase(const Params& p, char* lds) {
  char* ws = p.ws;
  if constexpr (PH == 0) phase_prologue(p);
  else if constexpr (PH == 1) phase_pool_gemm(p, lds);
  else if constexpr (PH == 2) phase_ln(p, p.ln_mix_g, p.ln_mix_b, (float*)(ws + OFF_H0F), (bf16_t*)(ws + OFF_H0B));
  else if constexpr (PH == 3) phase_router_gemm(p, lds, 0);
  else if constexpr (PH == 4) phase_route(p, 0);
  else if constexpr (PH == 5) phase_moe(p, lds, 0);
  else if constexpr (PH == 6) phase_combine_ln(p, (const float*)(ws + OFF_H0F), p.ln_ffn_g, p.ln_ffn_b, (float*)(ws + OFF_H1F), (bf16_t*)(ws + OFF_H1B));
  else if constexpr (PH == 7) phase_wa_gemm(p, lds);
  else if constexpr (PH == 8) phase_mla_rows(p);
  else if constexpr (PH == 9) phase_qkv_gemm(p, lds);
  else if constexpr (PH == 10) phase_attn(p, lds);
  else if constexpr (PH == 11) phase_wo_gemm(p, lds);
  else if constexpr (PH == 12) phase_ln(p, p.ln_mix_g + DM, p.ln_mix_b + DM, (float*)(ws + OFF_H0F), (bf16_t*)(ws + OFF_H0B));
  else if constexpr (PH == 13) phase_router_gemm(p, lds, 1);
  else if constexpr (PH == 14) phase_route(p, 1);
  else if constexpr (PH == 15) phase_moe(p, lds, 1);
  else if constexpr (PH == 16) phase_combine_ln(p, (const float*)(ws + OFF_H0F), p.ln_ffn_g + DM, p.ln_ffn_b + DM, p.out, nullptr);
}

template <int PH> __global__ void __launch_bounds__(NTHR, 2) k_phase(Params p) {
  extern __shared__ __attribute__((aligned(16))) char lds[];
  run_phase<PH>(p, lds);
}

template <int PH> __device__ __forceinline__ void run_all(const Params& p, char* lds, const XcdBarrier& bar) {
  run_phase<PH>(p, lds);
  if constexpr (PH + 1 < NPHASE) { xcd_barrier(bar); run_all<PH + 1>(p, lds, bar); }
}
__global__ void __launch_bounds__(NTHR, 2) k_mega(Params p) {
  extern __shared__ __attribute__((aligned(16))) char lds[];
  uint4* xbw = reinterpret_cast<uint4*>(lds + LDS_BYTES);
  if (threadIdx.x == 0) *xbw = make_uint4(0u, 0u, 0u, 0u);
  __syncthreads();
  XcdBarrier bar = xcd_barrier_post((unsigned*)(p.ws + OFF_BAR), (volatile LAS unsigned*)xbw);
  run_all<0>(p, lds, bar);
}

#if DBG
__device__ __forceinline__ void dbg_max(float* slot, float v) { atomicMax((unsigned*)slot, __float_as_uint(v)); }
__global__ void chk_gemm(const bf16_t* A, int lda, const float* W, int ldw, int K, int N, const float* Cf, const bf16_t* Cb, int ldc, int mode, const Params p, float* slot, float scale) {
  const int s = blockIdx.x * blockDim.x + threadIdx.x;
  const int t = (int)(((unsigned)s * 2654435761u) % NTOK), n = (int)(((unsigned)s * 40503u + 17u) % (unsigned)N);
  float ref = 0.f;
  for (int k = 0; k < K; ++k) ref += bf2f(A[(size_t)t * lda + k]) * W[(size_t)k * ldw + n];
  float got;
  if (mode == 0) got = Cf[(size_t)t * ldc + n];
  else if (mode == 1) { got = Cf[(size_t)t * ldc + n]; ref = (ref + p.pool_b[n]) * p.pool_scale[n] + ALPHA * p.x[(size_t)t * DM + n]; }
  else if (mode == 2) { got = Cf[(size_t)t * ldc + n] - ALPHA * ((const float*)(p.ws + OFF_H1F))[(size_t)t * DM + n]; }
  else if (mode == 3) got = bf2f(Cb[(size_t)t * ldc + n]);
  else if (mode == 4) got = bf2f(Cb[(size_t)t * ldc + (n >> 7) * 192 + (n & 127)]);
  else {
    const int h = n / 192, d = n % 192;
    got = bf2f(Cb[(size_t)t * ldc + n]);
    if (d >= 128) {
      const int j = (d - 128) & 31; const bool second = d >= 160;
      const int n1 = h * 192 + 128 + j, n2 = n1 + 32;
      float x1 = 0.f, x2 = 0.f;
      for (int k = 0; k < K; ++k) { const float a = bf2f(A[(size_t)t * lda + k]); x1 += a * W[(size_t)k * ldw + n1]; x2 += a * W[(size_t)k * ldw + n2]; }
      const int pos = t & (SEQ - 1);
      const double inv = pow(10000.0, -(double)(2 * j) / 64.0), ang = pos * inv;
      const float c = (float)cos(ang), sn = (float)sin(ang);
      ref = second ? x1 * sn + x2 * c : x1 * c - x2 * sn;
    }
  }
  dbg_max(slot, fabsf(got - ref) / (fabsf(ref) + scale));
}
__global__ void chk_pool(const Params p, float* slot) {
  const int s = blockIdx.x * blockDim.x + threadIdx.x;
  const int t = (int)(((unsigned)s * 2654435761u) % NTOK), n = (int)(((unsigned)s * 40503u + 17u) % DM);
  const int g = n >> 8, half = 1 << g, pos = t & (SEQ - 1), tb = t - pos;
  const float* x = p.x; const bf16_t* pooled = (const bf16_t*)(p.ws + OFF_POOLED);
  float ref = 0.f;
  for (int k = 0; k < 256; ++k) {
    const int c = g * 256 + k; float sum = 0.f; int cn = 0;
    for (int r = pos - half; r < pos + half; ++r) if (r >= 0 && r < SEQ) { sum += x[(size_t)(tb + r) * DM + c]; ++cn; }
    const float pl = sum / cn - x[(size_t)t * DM + c];
    if (k == (n & 255)) dbg_max(slot, fabsf(bf2f(pooled[(size_t)t * DM + c]) - pl) / (fabsf(pl) + 0.5f));
    ref += pl * p.pool_w[((size_t)g * 256 + k) * 256 + (n & 255)];
  }
  ref = (ref + p.pool_b[n]) * p.pool_scale[n] + ALPHA * x[(size_t)t * DM + n];
  dbg_max(slot + 1, fabsf(((const float*)(p.ws + OFF_Z))[(size_t)t * DM + n] - ref) / (fabsf(ref) + 0.5f));
}
__global__ void chk_route(const Params p, int layer, float* slot) {
  const int s = blockIdx.x * blockDim.x + threadIdx.x;
  const int t = (int)(((unsigned)s * 2654435761u) % NTOK);
  const float* lg = (const float*)(p.ws + OFF_LOGIT) + (size_t)t * NEXP;
  const float* rb = p.router_b + layer * NEXP;
  float gs[8];
  for (int g = 0; g < 8; ++g) { float m1 = -1e30f, m2 = -1e30f; for (int k = 0; k < 32; ++k) { const float v = 1.f / (1.f + expf(-lg[g * 32 + k])) + rb[g * 32 + k]; if (v > m1) { m2 = m1; m1 = v; } else if (v > m2) m2 = v; } gs[g] = m1 + m2; }
  bool sel[8];
  for (int g = 0; g < 8; ++g) { int rank = 0; for (int g2 = 0; g2 < 8; ++g2) rank += (gs[g2] > gs[g] || (gs[g2] == gs[g] && g2 < g)); sel[g] = rank < 4; }
  int ei[8]; float es[8]; float ssum = 0.f; unsigned long long used[4] = {0, 0, 0, 0};
  for (int kk = 0; kk < 8; ++kk) { float best = -1e30f; int bi = -1;
    for (int e = 0; e < 256; ++e) { if (!sel[e >> 5] || ((used[e >> 6] >> (e & 63)) & 1)) continue; const float v = 1.f / (1.f + expf(-lg[e])) + rb[e]; if (v > best) { best = v; bi = e; } }
    used[bi >> 6] |= 1ull << (bi & 63); ei[kk] = bi; es[kk] = 1.f / (1.f + expf(-lg[bi])); ssum += es[kk]; }
  const int* texp = (const int*)(p.ws + OFF_TEXP); const float* gate = (const float*)(p.ws + OFF_GATE);
  float err = 0.f;
  for (int kk = 0; kk < 8; ++kk) { if (texp[t * 8 + kk] != ei[kk]) err = 10.f; err = fmaxf(err, fabsf(gate[t * 8 + kk] - es[kk] / ssum * 2.5f)); }
  const int* cnt = (const int*)(p.ws + OFF_CNT) + layer * NEXP; const int* list = (const int*)(p.ws + OFF_LIST);
  const int e = s & 255; const int c = cnt[e];
  if (c > 0) { const int idx = (int)(((unsigned)s * 7919u) % (unsigned)c); const int ent = list[(size_t)e * NTOK + idx]; if (ent < 0 || ent >= NTOK * 8 || texp[ent] != e) err = 20.f; }
  if (s == 0) { int tot = 0; for (int i = 0; i < 256; ++i) tot += cnt[i]; if (tot != NTOK * 8) err = 30.f; }
  dbg_max(slot, err);
}
__global__ void chk_moe(const Params p, int layer, float* slot) {
  __shared__ float hbs[256];
  const int s = blockIdx.x; const int t = (int)(((unsigned)s * 2654435761u + 12345u) % NTOK), k = s % 9;
  const bf16_t* h = (const bf16_t*)(p.ws + OFF_H0B) + (size_t)t * DM;
  const int* texp = (const int*)(p.ws + OFF_TEXP); const float* gate = (const float*)(p.ws + OFF_GATE);
  const float *wg, *wu, *wd; float g = 1.f; const bf16_t* y;
  if (k == 8) { wg = p.sw_gate + (size_t)layer * DM * EFF; wu = p.sw_up + (size_t)layer * DM * EFF; wd = p.sw_down + (size_t)layer * EFF * DM; y = (const bf16_t*)(p.ws + OFF_YSH) + (size_t)t * DM; }
  else { const int e = texp[t * 8 + k]; const size_t eo = (size_t)layer * NEXP + e; wg = p.ew_gate + eo * DM * EFF; wu = p.ew_up + eo * DM * EFF; wd = p.ew_down + eo * EFF * DM; g = gate[t * 8 + k]; y = (const bf16_t*)(p.ws + OFF_Y) + ((size_t)t * 8 + k) * DM; }
  const int f = threadIdx.x; float a = 0.f, b = 0.f;
  for (int d = 0; d < DM; ++d) { const float hv = bf2f(h[d]); a += hv * wg[(size_t)d * EFF + f]; b += hv * wu[(size_t)d * EFF + f]; }
  hbs[f] = a / (1.f + expf(-a)) * b;
  __syncthreads();
  for (int n = f; n < DM; n += 256) { float r = 0.f; for (int ff = 0; ff < EFF; ++ff) r += hbs[ff] * wd[(size_t)ff * DM + n]; r *= g;
    dbg_max(slot, fabsf(bf2f(y[n]) - r) / (fabsf(r) + 0.05f)); }
}
__global__ void chk_ln(const Params p, const float* zin, int combine, const float* hres, const float* g, const float* b, const float* of, float* slot) {
  const int s = blockIdx.x * blockDim.x + threadIdx.x; const int t = (int)(((unsigned)s * 2654435761u + 99u) % NTOK);
  const bf16_t* Y = (const bf16_t*)(p.ws + OFF_Y); const bf16_t* Ysh = (const bf16_t*)(p.ws + OFF_YSH);
  double mu = 0, var = 0;
  auto val = [&](int c) -> float { if (!combine) return zin[(size_t)t * DM + c]; float v = ALPHA * hres[(size_t)t * DM + c] + bf2f(Ysh[(size_t)t * DM + c]); for (int k = 0; k < 8; ++k) v += bf2f(Y[((size_t)t * 8 + k) * DM + c]); return v; };
  for (int c = 0; c < DM; ++c) mu += val(c);
  mu /= DM;
  for (int c = 0; c < DM; ++c) { const double d = val(c) - mu; var += d * d; }
  var /= DM; const float rstd = (float)(1.0 / sqrt(var + 1e-5));
  float err = 0.f;
  for (int c = 0; c < DM; c += 7) { const float ref = (float)(val(c) - mu) * rstd * g[c] + b[c]; err = fmaxf(err, fabsf(of[(size_t)t * DM + c] - ref) / (fabsf(ref) + 0.5f)); }
  dbg_max(slot, err);
}
__global__ void chk_mla_rows(const Params p, float* slot) {
  const int s = blockIdx.x * blockDim.x + threadIdx.x; const int t = (int)(((unsigned)s * 2654435761u + 7u) % NTOK);
  const float* a = (const float*)(p.ws + OFF_ABUF) + (size_t)t * WA_NP;
  const bf16_t* ql = (const bf16_t*)(p.ws + OFF_QLAT) + (size_t)t * QL; const bf16_t* kvl = (const bf16_t*)(p.ws + OFF_KVLAT) + (size_t)t * KVL; const bf16_t* Kb = (const bf16_t*)(p.ws + OFF_K) + (size_t)t * 1536;
  double sq = 0, sk = 0; for (int i = 0; i < QL; ++i) sq += (double)a[i] * a[i]; for (int i = 0; i < KVL; ++i) sk += (double)a[QL + i] * a[QL + i];
  const float rq = (float)(1.0 / sqrt(sq / QL + 1e-6)), rk = (float)(1.0 / sqrt(sk / KVL + 1e-6));
  float err = 0.f;
  for (int i = 0; i < QL; ++i) { const float r = a[i] * rq * p.qn_g[i]; err = fmaxf(err, fabsf(bf2f(ql[i]) - r) / (fabsf(r) + 0.5f)); }
  for (int i = 0; i < KVL; ++i) { const float r = a[QL + i] * rk * p.kvn_g[i]; err = fmaxf(err, fabsf(bf2f(kvl[i]) - r) / (fabsf(r) + 0.5f)); }
  const int pos = t & (SEQ - 1);
  for (int j = 0; j < 32; ++j) { const double inv = pow(10000.0, -(double)(2 * j) / 64.0), ang = pos * inv; const float c = (float)cos(ang), sn = (float)sin(ang);
    const float x1 = a[640 + j], x2 = a[672 + j]; const float r1 = x1 * c - x2 * sn, r2 = x1 * sn + x2 * c;
    for (int h = 0; h < NH; h += 3) { err = fmaxf(err, fabsf(bf2f(Kb[h * 192 + 128 + j]) - r1) / (fabsf(r1) + 0.5f)); err = fmaxf(err, fabsf(bf2f(Kb[h * 192 + 160 + j]) - r2) / (fabsf(r2) + 0.5f)); } }
  dbg_max(slot, err);
}
__global__ void chk_attn(const Params p, float* slot) {
  __shared__ float red[256]; __shared__ float qs[192]; __shared__ float osum[128];
  const int s = blockIdx.x; const int t = (int)(((unsigned)s * 2654435761u + 5u) % NTOK), h = s & 7;
  const int b = t >> 13; const size_t t0 = (size_t)b * SEQ;
  const bf16_t* Q = (const bf16_t*)(p.ws + OFF_Q) + (size_t)t * 1536 + h * 192;
  const bf16_t* Kb = (const bf16_t*)(p.ws + OFF_K) + t0 * 1536 + h * 192; const bf16_t* V = (const bf16_t*)(p.ws + OFF_V) + t0 * 1024 + h * 128;
  const bf16_t* O = (const bf16_t*)(p.ws + OFF_O) + (size_t)t * 1024 + h * 128;
  const int tid = threadIdx.x;
  if (tid < 192) qs[tid] = bf2f(Q[tid]); if (tid < 128) osum[tid] = 0.f;
  __syncthreads();
  float sc[32]; float mx = -1e30f;
  for (int i = 0; i < 32; ++i) { const int key = tid + 256 * i; float d = 0.f; for (int c = 0; c < 192; ++c) d += qs[c] * bf2f(Kb[(size_t)key * 1536 + c]); sc[i] = d * 0.07216878364870323f; mx = fmaxf(mx, sc[i]); }
  red[tid] = mx; __syncthreads();
  for (int o = 128; o > 0; o >>= 1) { if (tid < o) red[tid] = fmaxf(red[tid], red[tid + o]); __syncthreads(); }
  mx = red[0]; __syncthreads();
  float sum = 0.f; for (int i = 0; i < 32; ++i) { sc[i] = expf(sc[i] - mx); sum += sc[i]; }
  red[tid] = sum; __syncthreads();
  for (int o = 128; o > 0; o >>= 1) { if (tid < o) red[tid] += red[tid + o]; __syncthreads(); }
  sum = red[0]; __syncthreads();
  for (int d = 0; d < 128; ++d) { float a = 0.f; for (int i = 0; i < 32; ++i) a += sc[i] * bf2f(V[(size_t)(tid + 256 * i) * 1024 + d]); atomicAdd(&osum[d], a); }
  __syncthreads();
  if (tid < 128) { const float r = osum[tid] / sum; dbg_max(slot, fabsf(bf2f(O[tid]) - r) / (fabsf(r) + 0.01f)); }
}
__global__ void dbg_report(const float* err, int nstage, float tol, float* out, int n) {
  int first = -1;
  for (int i = 0; i < nstage; ++i) if (!(err[i] <= tol)) { first = i; break; }
  if (first < 0) return;
  float e = err[first]; float m = 1.f + 2.f * log10f(fmaxf(e / tol, 1.f)); if (!(m < 9.5f)) m = 9.5f;
  const float v = m * powf(10.f, 3.f + first);
  for (int i = blockIdx.x * blockDim.x + threadIdx.x; i < n; i += gridDim.x * blockDim.x) out[i] = v;
}
#endif

template <int PH> static void launch_phase(const Params& p, int grid, hipStream_t stream) {
  static bool attr = false;
  if (!attr) { hipFuncSetAttribute((const void*)k_phase<PH>, hipFuncAttributeMaxDynamicSharedMemorySize, LDS_BYTES + 16); attr = true; }
  hipLaunchKernelGGL(k_phase<PH>, dim3(grid), dim3(NTHR), LDS_BYTES + 16, stream, p);
}
template <int PH> static void launch_range(const Params& p, int grid, hipStream_t stream, int last) {
  if (PH <= last) launch_phase<PH>(p, grid, stream);
  if constexpr (PH + 1 < NPHASE) launch_range<PH + 1>(p, grid, stream, last);
}

extern "C" void kernel_launch(void* const* d_in, const int* in_sizes, int n_in, void* d_out, int out_size, void* d_ws, size_t ws_size, hipStream_t stream) {
  static int grid = 0;
  if (!grid) {
    int dev = 0, cus = 0; hipGetDevice(&dev); hipDeviceGetAttribute(&cus, hipDeviceAttributeMultiprocessorCount, dev);
    if (cus <= 0) cus = 256;
    hipFuncSetAttribute((const void*)k_mega, hipFuncAttributeMaxDynamicSharedMemorySize, LDS_BYTES + 16);
    int per_cu = 0; hipOccupancyMaxActiveBlocksPerMultiprocessor(&per_cu, k_mega, NTHR, LDS_BYTES + 16);
    if (per_cu < 1) fprintf(stderr, "kernel_launch: occupancy query says %d blocks/CU\n", per_cu);
    grid = cus;
    if (ws_size < WS_END) fprintf(stderr, "kernel_launch: workspace too small: %zu < %zu\n", ws_size, WS_END);
  }
  Params p{};
  const float* const* in = (const float* const*)d_in;
  p.x = in[0]; p.pool_w = in[1]; p.pool_b = in[2]; p.pool_scale = in[3]; p.w_a = in[4]; p.qn_g = in[5]; p.kvn_g = in[6]; p.w_uq = in[7]; p.w_uk = in[8]; p.w_uv = in[9]; p.w_o = in[10];
  p.ln_mix_g = in[11]; p.ln_mix_b = in[12]; p.router_w = in[13]; p.router_b = in[14]; p.ew_gate = in[15]; p.ew_up = in[16]; p.ew_down = in[17];
  p.sw_gate = in[18]; p.sw_up = in[19]; p.sw_down = in[20]; p.ln_ffn_g = in[21]; p.ln_ffn_b = in[22];
  p.out = (float*)d_out; p.ws = (char*)d_ws;
  hipMemsetAsync((char*)d_ws + OFF_BAR, 0, 32768, stream);
#if MK_SINGLE
  hipLaunchKernelGGL(k_mega, dim3(grid), dim3(NTHR), LDS_BYTES + 16, stream, p);
#else
  launch_range<0>(p, grid, stream, NPHASE - 1);
#endif
#if DBG
  {
    char* ws = (char*)d_ws; float* err = (float*)(ws + OFF_DBG);
    const bf16_t* h0b = (const bf16_t*)(ws + OFF_H0B); const bf16_t* h1b = (const bf16_t*)(ws + OFF_H1B);
    chk_gemm<<<16, 256, 0, stream>>>(h0b, DM, p.router_w + (size_t)DM * NEXP, NEXP, DM, NEXP, (const float*)(ws + OFF_LOGIT), nullptr, NEXP, 0, p, err + 0, 0.5f);
    chk_route<<<16, 256, 0, stream>>>(p, 1, err + 1);
    chk_moe<<<72, 256, 0, stream>>>(p, 1, err + 2);
    chk_ln<<<4, 64, 0, stream>>>(p, nullptr, 1, (const float*)(ws + OFF_H0F), p.ln_ffn_g + DM, p.ln_ffn_b + DM, p.out, err + 3);
    chk_gemm<<<16, 256, 0, stream>>>(h1b, DM, p.w_a, WA_N, DM, WA_N, (const float*)(ws + OFF_ABUF), nullptr, WA_NP, 0, p, err + 4, 0.5f);
    chk_mla_rows<<<4, 64, 0, stream>>>(p, err + 5);
    chk_gemm<<<16, 256, 0, stream>>>((const bf16_t*)(ws + OFF_QLAT), QL, p.w_uq, 1536, QL, 1536, nullptr, (const bf16_t*)(ws + OFF_Q), 1536, 5, p, err + 6, 0.5f);
    chk_gemm<<<16, 256, 0, stream>>>((const bf16_t*)(ws + OFF_KVLAT), KVL, p.w_uk, 1024, KVL, 1024, nullptr, (const bf16_t*)(ws + OFF_K), 1536, 4, p, err + 7, 0.5f);
    chk_gemm<<<16, 256, 0, stream>>>((const bf16_t*)(ws + OFF_KVLAT), KVL, p.w_uv, 1024, KVL, 1024, nullptr, (const bf16_t*)(ws + OFF_V), 1024, 3, p, err + 8, 0.25f);
    chk_attn<<<64, 256, 0, stream>>>(p, err + 9);
    chk_gemm<<<16, 256, 0, stream>>>((const bf16_t*)(ws + OFF_O), DM, p.w_o, DM, DM, DM, (const float*)(ws + OFF_Z), nullptr, DM, 2, p, err + 10, 0.003f);
    chk_ln<<<4, 64, 0, stream>>>(p, (const float*)(ws + OFF_Z), 0, nullptr, p.ln_mix_g + DM, p.ln_mix_b + DM, (const float*)(ws + OFF_H0F), err + 11);
    dbg_report<<<256, 256, 0, stream>>>(err, 12, 0.03f, p.out, out_size);
  }
#endif
  const hipError_t le = hipPeekAtLastError();
  if (le != hipSuccess) fprintf(stderr, "kernel_launch: launch failed: %s\n", hipGetErrorName(le));
}
```

```cpp
#include <hip/hip_runtime.h>
#include <stdint.h>
#include <stdio.h>

#ifndef MK_SINGLE
#define MK_SINGLE 1
#endif
#ifndef DBG
#define DBG 0
#endif
#ifndef PROBE_T
#define PROBE_T 0
#endif
#ifndef PROBE_A0
#define PROBE_A0 11
#define PROBE_A1 12
#define PROBE_SCALE 0.2f
#endif
#define BENCH_MODE 2
#ifndef MOE_HACK
#define MOE_HACK 0
#endif
#ifndef REP_MASK
#define REP_MASK 0
#endif

constexpr int NTOK = 16384, DM = 1024, SEQ = 8192;
constexpr int NEXP = 256, EFF = 256, TOPK = 8;
constexpr int QL = 384, KVL = 256, NH = 8, DQK = 192, DNOPE = 128, DROPE = 64, DVH = 128;
constexpr int WA_N = 704, WA_NP = 768;
constexpr float ALPHA = 1.4142135623730951f;
constexpr float LN_EPS = 1e-5f, RMS_EPS = 1e-6f;
constexpr int NTHR = 512;

typedef unsigned short bf16_t;
typedef __attribute__((ext_vector_type(8))) short bf16x8;
typedef __attribute__((ext_vector_type(4))) short s16x4;
typedef __attribute__((ext_vector_type(16))) float f32x16;
typedef __attribute__((ext_vector_type(4))) float f32x4;
typedef __attribute__((ext_vector_type(2))) float f32x2;
typedef __attribute__((ext_vector_type(4))) unsigned u32x4;
typedef __attribute__((ext_vector_type(2))) unsigned u32x2;

constexpr size_t al256(size_t x) { return (x + 255) / 256 * 256; }
constexpr size_t OFF_BAR = 0;
constexpr size_t OFF_DBG = 16384;
constexpr size_t OFF_CNT = 32768;
constexpr int CNT_STRIDE = 32;
constexpr size_t OFF_ROPE = 65536;
constexpr size_t OFF_WPOOL = OFF_ROPE + 2 * (size_t)SEQ * 32 * 4;
constexpr size_t OFF_WR = OFF_WPOOL + (size_t)4 * 256 * 256 * 2;
constexpr size_t OFF_WA = OFF_WR + (size_t)2 * DM * NEXP * 2;
constexpr size_t OFF_WUQ = OFF_WA + (size_t)DM * WA_NP * 2;
constexpr size_t OFF_WUK = OFF_WUQ + (size_t)QL * 1536 * 2;
constexpr size_t OFF_WUV = OFF_WUK + (size_t)KVL * 1024 * 2;
constexpr size_t OFF_WO = OFF_WUV + (size_t)KVL * 1024 * 2;
constexpr size_t OFF_SWG = OFF_WO + (size_t)DM * DM * 2;
constexpr size_t OFF_SWU = OFF_SWG + (size_t)2 * DM * EFF * 2;
constexpr size_t OFF_SWD = OFF_SWU + (size_t)2 * DM * EFF * 2;
constexpr size_t OFF_POOLED = OFF_SWD + (size_t)2 * EFF * DM * 2;
constexpr size_t OFF_Z = OFF_POOLED + (size_t)NTOK * DM * 2;
constexpr size_t OFF_H0F = OFF_Z + (size_t)NTOK * DM * 4;
constexpr size_t OFF_CNTP = OFF_H0F;
constexpr size_t OFF_GLIST = OFF_H0F + (1u << 20);
constexpr size_t OFF_H0B = OFF_H0F + (size_t)NTOK * DM * 4;
constexpr size_t OFF_H1F = OFF_H0B + (size_t)NTOK * DM * 2;
constexpr size_t OFF_H1B = OFF_H1F + (size_t)NTOK * DM * 4;
constexpr size_t OFF_LOGIT = OFF_H1B + (size_t)NTOK * DM * 2;
constexpr size_t OFF_LIST = OFF_LOGIT + (size_t)NTOK * NEXP * 4;
constexpr size_t OFF_GATE = OFF_LIST + (size_t)NEXP * NTOK * 4;
constexpr size_t OFF_TEXP = OFF_GATE + (size_t)NTOK * TOPK * 4;
constexpr size_t OFF_Y = OFF_TEXP + (size_t)NTOK * TOPK * 4;
constexpr size_t OFF_YSH = OFF_Y + (size_t)NTOK * TOPK * DM * 2;
constexpr size_t OFF_ABUF = OFF_YSH + (size_t)NTOK * DM * 2;
constexpr size_t OFF_QLAT = OFF_ABUF + (size_t)NTOK * WA_NP * 4;
constexpr size_t OFF_KVLAT = OFF_QLAT + (size_t)NTOK * QL * 2;
constexpr size_t OFF_Q = OFF_KVLAT + (size_t)NTOK * KVL * 2;
constexpr size_t OFF_K = OFF_Q + (size_t)NTOK * 1536 * 2;
constexpr size_t OFF_V = OFF_K + (size_t)NTOK * 1536 * 2;
constexpr size_t OFF_O = OFF_V + (size_t)NTOK * 1024 * 2;
constexpr size_t WS_END = OFF_O + (size_t)NTOK * 1024 * 2;

struct Params {
  const float *x, *pool_w, *pool_b, *pool_scale, *w_a, *qn_g, *kvn_g, *w_uq, *w_uk, *w_uv, *w_o;
  const float *ln_mix_g, *ln_mix_b, *router_w, *router_b, *ew_gate, *ew_up, *ew_down, *sw_gate, *sw_up, *sw_down, *ln_ffn_g, *ln_ffn_b;
  float* out;
  char* ws;
};

#define XB_TMO      128
#define XB_XCNT(j)  (256  + 64 * (j))
#define XB_XSUB(j)  (1280 + 64 * (j))
#define XB_XGEN(j)  (2304 + 64 * (j))
#define XB_TOP      3328
#define XB_TOPGEN   3392
#define XCD_BAR_WORDS 3456
#define XB_SPIN_CAP (1u << 20)
#define LAS __attribute__((address_space(3)))

__device__ __forceinline__ unsigned xb_ld(unsigned* p)              { return __hip_atomic_load(p, __ATOMIC_RELAXED, __HIP_MEMORY_SCOPE_AGENT); }
__device__ __forceinline__ unsigned xb_add(unsigned* p, unsigned v) { return __hip_atomic_fetch_add(p, v, __ATOMIC_RELAXED, __HIP_MEMORY_SCOPE_AGENT); }
__device__ __forceinline__ unsigned xb_xcc_id() { return (unsigned)__builtin_amdgcn_s_getreg((3 << 11) | 20) & 0xFu; }
#define XB_SPIN(cond, bar) do { unsigned _sp = 0; while (cond) { __builtin_amdgcn_s_sleep(1); \
    if ((++_sp & 255u) == 0u) { if (xb_ld(&(bar)[XB_TMO])) break; if (_sp > XB_SPIN_CAP) { atomicAdd(&(bar)[XB_TMO], 1u); break; } } } } while (0)

struct XcdBarrier { unsigned* bar; unsigned x; volatile LAS unsigned* st; };

__device__ __forceinline__ XcdBarrier xcd_barrier_post(unsigned* bar, volatile LAS unsigned* st) {
    XcdBarrier b; b.bar = bar; b.x = xb_xcc_id(); b.st = st;
    if (threadIdx.x == 0) (void)xb_add(&bar[XB_XCNT(b.x)], 1u);
    return b;
}
__device__ __forceinline__ void xcd_barrier_complete(unsigned* bar, unsigned x, unsigned& nloc, unsigned& nx) {
    const unsigned G = gridDim.x * gridDim.y * gridDim.z;
    unsigned sum, cnt, mine, sp = 0u;
    for (;;) {
        sum = 0u; cnt = 0u; mine = 0u;
#pragma unroll
        for (unsigned j = 0; j < 16; ++j) { const unsigned c = xb_ld(&bar[XB_XCNT(j)]); sum += c; cnt += (c > 0u) ? 1u : 0u; mine = (j == x) ? c : mine; }
        if (sum == G) break;
        __builtin_amdgcn_s_sleep(1);
        if ((++sp & 255u) == 0u) { if (xb_ld(&bar[XB_TMO])) break; if (sp > XB_SPIN_CAP) { atomicAdd(&bar[XB_TMO], 1u); break; } }
    }
    nloc = mine > 0u ? mine : 1u; nx = cnt > 0u ? cnt : 1u;
}
__device__ __forceinline__ void xcd_barrier(const XcdBarrier& b) {
    asm volatile("s_waitcnt vmcnt(0)" ::: "memory");
    __syncthreads();
    if (threadIdx.x == 0) {
        unsigned* bar = b.bar;
        __builtin_amdgcn_s_waitcnt(0);
        unsigned nloc = b.st[0], nx = b.st[1];
        if (nloc == 0u) { xcd_barrier_complete(bar, b.x, nloc, nx); b.st[0] = nloc; b.st[1] = nx; }
        const unsigned old = xb_add(&bar[XB_XSUB(b.x)], 1u);
        const unsigned gen = old / nloc;
        if (old + 1u == (gen + 1u) * nloc) {
            __builtin_amdgcn_fence(__ATOMIC_RELEASE, "agent");
            asm volatile("s_waitcnt vmcnt(0)" ::: "memory");
            const unsigned og = xb_add(&bar[XB_TOP], 1u);
            const unsigned tg = og / nx;
            if (og + 1u == (tg + 1u) * nx) xb_add(&bar[XB_TOPGEN], 1u);
            else XB_SPIN(xb_ld(&bar[XB_TOPGEN]) == tg, bar);
            __builtin_amdgcn_fence(__ATOMIC_ACQUIRE, "agent");
            xb_add(&bar[XB_XGEN(b.x)], 1u);
            asm volatile("s_waitcnt vmcnt(0)" ::: "memory");
        } else {
            XB_SPIN(xb_ld(&bar[XB_XGEN(b.x)]) == gen, bar);
            __builtin_amdgcn_fence(__ATOMIC_ACQUIRE, "agent");
            asm volatile("s_waitcnt vmcnt(0)" ::: "memory");
        }
    }
    __syncthreads();
}


constexpr size_t OFF_XCENSUS = 17408;
constexpr size_t OFF_RBAR = 18432;
struct Deal { int xg, rk, ng, ngroups; bool census; };
__device__ __forceinline__ Deal get_deal(const Params& p, const char* lds_end_words) {
  const unsigned* w = reinterpret_cast<const unsigned*>(lds_end_words);
  const unsigned myx = w[2], myr = w[3];
  Deal d;
  if (myx == ~0u) { d.xg = blockIdx.x & 7; d.rk = blockIdx.x >> 3; d.ng = ((int)gridDim.x + 7 - d.xg) >> 3; d.ngroups = 8; d.census = false; return d; }
  unsigned* cen = (unsigned*)(p.ws + OFF_XCENSUS);
  int ngroups = 0, xg = 0, ng = 1;
#pragma unroll
  for (int j = 0; j < 16; ++j) { const unsigned c = xb_ld(&cen[j]); ngroups += c > 0u; xg += (c > 0u && (unsigned)j < myx); if ((unsigned)j == myx) ng = (int)c; }
  d.xg = __builtin_amdgcn_readfirstlane(xg); d.rk = __builtin_amdgcn_readfirstlane((int)myr); d.ng = __builtin_amdgcn_readfirstlane(ng); d.ngroups = __builtin_amdgcn_readfirstlane(ngroups); d.census = true;
  return d;
}
__device__ __forceinline__ void round_barrier(const Params& p, const char* lds_end_words, int layer, int round, int ng) {
  __syncthreads();
  if (threadIdx.x == 0) {
    const unsigned myx = reinterpret_cast<const unsigned*>(lds_end_words)[2];
    unsigned* wd = (unsigned*)(p.ws + OFF_RBAR) + (layer * 16 + (int)myx) * 16;
    xb_add(wd, 1u);
    const unsigned target = (unsigned)((round + 1) * ng);
    unsigned sp = 0;
    while (xb_ld(wd) < target) { __builtin_amdgcn_s_sleep(2); if (++sp > (1u << 16)) break; }
  }
  __syncthreads();
}

__device__ __forceinline__ int opaque_tid() { int t = threadIdx.x; asm volatile("" : "+v"(t)); return t; }
#define SBAR() __builtin_amdgcn_sched_barrier(0)
__device__ __forceinline__ int crow(int r, int hi) { return (r & 3) + 8 * (r >> 2) + 4 * hi; }
__device__ __forceinline__ unsigned cvtpk(float lo, float hi) {
  unsigned r; asm("v_cvt_pk_bf16_f32 %0, %1, %2" : "=v"(r) : "v"(lo), "v"(hi)); return r;
}
__device__ __forceinline__ bf16_t f2bf(float f) { return (bf16_t)(cvtpk(f, 0.f) & 0xffffu); }
__device__ __forceinline__ float bf2f(bf16_t b) { return __uint_as_float(((unsigned)b) << 16); }
__device__ __forceinline__ bf16x8 cvt8(f32x4 a, f32x4 b) {
  u32x4 w = {cvtpk(a[0], a[1]), cvtpk(a[2], a[3]), cvtpk(b[0], b[1]), cvtpk(b[2], b[3])};
  return *reinterpret_cast<bf16x8*>(&w);
}
template <int CTRL> __device__ __forceinline__ float dppf(float v) { return __int_as_float(__builtin_amdgcn_update_dpp(0, __float_as_int(v), CTRL, 0xf, 0xf, false)); }
constexpr int DPP_XOR1 = 0xB1, DPP_XOR2 = 0x4E, DPP_HALF_MIRROR = 0x141, DPP_MIRROR = 0x140;
__device__ __forceinline__ float rdlane(float v, int l) { return __int_as_float(__builtin_amdgcn_readlane(__float_as_int(v), l)); }
__device__ __forceinline__ float wave_sum(float v) {
  v += dppf<DPP_XOR1>(v); v += dppf<DPP_XOR2>(v); v += dppf<DPP_HALF_MIRROR>(v); v += dppf<DPP_MIRROR>(v);
  return (rdlane(v, 0) + rdlane(v, 16)) + (rdlane(v, 32) + rdlane(v, 48));
}
__device__ __forceinline__ float wave_max(float v) {
  v = fmaxf(v, dppf<DPP_XOR1>(v)); v = fmaxf(v, dppf<DPP_XOR2>(v)); v = fmaxf(v, dppf<DPP_HALF_MIRROR>(v)); v = fmaxf(v, dppf<DPP_MIRROR>(v));
  return fmaxf(fmaxf(rdlane(v, 0), rdlane(v, 16)), fmaxf(rdlane(v, 32), rdlane(v, 48)));
}

template <int BK> __device__ __forceinline__ int a_off(int row, int chunk) {
  if (BK == 32) return row * 64 + ((chunk ^ ((row >> 2) & 3)) << 4);
  else          return row * 128 + ((chunk ^ ((row >> 1) & 7)) << 4);
}
__device__ __forceinline__ int hb_off(int row, int chunk) { return row * 512 + ((chunk ^ (row & 15)) << 4); }
template <int BN> __device__ __forceinline__ int b_st_off(int k, int c) {
  const int kk = (k & ~0xC) | ((k & 4) << 1) | ((k & 8) >> 1);
  return ((kk >> 3) * (BN / 32) + (c >> 5)) * 512 + ((kk & 7) * 32 + (c & 31)) * 2;
}
__device__ __forceinline__ int v_rd_base(int lane) { return ((lane & 3) << 3) | (((lane >> 2) & 3) << 6) | (((lane >> 4) & 1) << 5) | (((lane >> 5) & 1) << 8); }
template <int OFF> __device__ __forceinline__ s16x4 tr_read(int addr) {
  s16x4 r; asm volatile("ds_read_b64_tr_b16 %0, %1 offset:%2" : "=&v"(r) : "v"(addr), "i"(OFF) : "memory"); return r;
}
#define PKF(L, H) (bf16x8){L[0], L[1], L[2], L[3], H[0], H[1], H[2], H[3]}

template <int BN, int BK> struct GC {
  static constexpr int NB = BN / 128;
  static constexpr int CH = BK / 8;
  static constexpr int A_BYTES = 128 * BK * 2;
  static constexpr int B_BYTES = BK * BN * 2;
  static constexpr int STAGE = A_BYTES + B_BYTES;
  static constexpr int BP = BK * BN / 4096;
  static constexpr int AP = 128 * CH / 512;
  static constexpr int CPR = BN / 8;
  static constexpr int RSTEP = 512 / CPR;
};

template <int BN, int S, bool SWAP, bool DUAL, class MID>
__device__ __forceinline__ void kstep(f32x16 (&acc)[2][BN / 128], bf16x8 a0, bf16x8 a1, int bb0, int bb1, MID&& mid) {
  constexpr int NB = BN / 128;
  constexpr int RS = (BN / 32) * 512;
  constexpr int O0 = (2 * S) * RS, O1 = (2 * S + 1) * RS;
  bf16x8 bf[2];
  if constexpr (NB == 2) {
    s16x4 l0 = tr_read<O0>(bb0), h0 = tr_read<O1>(bb0), l1 = tr_read<O0 + 512>(bb0), h1 = tr_read<O1 + 512>(bb0);
    asm volatile("s_waitcnt lgkmcnt(0)" ::: "memory"); SBAR();
    bf[0] = PKF(l0, h0); bf[1] = PKF(l1, h1);
  } else {
    {
      s16x4 l0 = tr_read<O0>(bb0), h0 = tr_read<O1>(bb0), l1 = tr_read<O0 + 512>(bb0), h1 = tr_read<O1 + 512>(bb0);
      asm volatile("s_waitcnt lgkmcnt(0)" ::: "memory"); SBAR();
      bf[0] = PKF(l0, h0); bf[1] = PKF(l1, h1);
    }
#pragma unroll
    for (int j = 0; j < 2; ++j) {
      if constexpr (SWAP) {
        acc[0][j] = __builtin_amdgcn_mfma_f32_32x32x16_bf16(bf[j], a0, acc[0][j], 0, 0, 0);
        acc[1][j] = __builtin_amdgcn_mfma_f32_32x32x16_bf16(bf[j], a1, acc[1][j], 0, 0, 0);
      } else {
        acc[0][j] = __builtin_amdgcn_mfma_f32_32x32x16_bf16(a0, bf[j], acc[0][j], 0, 0, 0);
        acc[1][j] = __builtin_amdgcn_mfma_f32_32x32x16_bf16(a1, bf[j], acc[1][j], 0, 0, 0);
      }
    }
    mid(2 * S);
    {
      s16x4 l2, h2, l3, h3;
      if constexpr (DUAL) { l2 = tr_read<O0>(bb1); h2 = tr_read<O1>(bb1); l3 = tr_read<O0 + 512>(bb1); h3 = tr_read<O1 + 512>(bb1); }
      else { l2 = tr_read<O0 + 1024>(bb0); h2 = tr_read<O1 + 1024>(bb0); l3 = tr_read<O0 + 1536>(bb0); h3 = tr_read<O1 + 1536>(bb0); }
      asm volatile("s_waitcnt lgkmcnt(0)" ::: "memory"); SBAR();
      bf[0] = PKF(l2, h2); bf[1] = PKF(l3, h3);
    }
#pragma unroll
    for (int j = 0; j < 2; ++j) {
      if constexpr (SWAP) {
        acc[0][j + 2] = __builtin_amdgcn_mfma_f32_32x32x16_bf16(bf[j], a0, acc[0][j + 2], 0, 0, 0);
        acc[1][j + 2] = __builtin_amdgcn_mfma_f32_32x32x16_bf16(bf[j], a1, acc[1][j + 2], 0, 0, 0);
      } else {
        acc[0][j + 2] = __builtin_amdgcn_mfma_f32_32x32x16_bf16(a0, bf[j], acc[0][j + 2], 0, 0, 0);
        acc[1][j + 2] = __builtin_amdgcn_mfma_f32_32x32x16_bf16(a1, bf[j], acc[1][j + 2], 0, 0, 0);
      }
    }
    mid(2 * S + 1);
    return;
  }
#pragma unroll
  for (int j = 0; j < 2; ++j) {
    if constexpr (SWAP) {
      acc[0][j] = __builtin_amdgcn_mfma_f32_32x32x16_bf16(bf[j], a0, acc[0][j], 0, 0, 0);
      acc[1][j] = __builtin_amdgcn_mfma_f32_32x32x16_bf16(bf[j], a1, acc[1][j], 0, 0, 0);
    } else {
      acc[0][j] = __builtin_amdgcn_mfma_f32_32x32x16_bf16(a0, bf[j], acc[0][j], 0, 0, 0);
      acc[1][j] = __builtin_amdgcn_mfma_f32_32x32x16_bf16(a1, bf[j], acc[1][j], 0, 0, 0);
    }
  }
  mid(S);
}

template <int BN, int BK, bool SWAP, bool AHB, bool DUAL, typename TB, int PF = 1>
__device__ __forceinline__ void gemm_core(f32x16 (&acc)[2][BN / 128], const char* abase, unsigned aoff0, unsigned aoff1,
                                          const char* bbase, unsigned boff, unsigned ldbB, int bk0, int bc, int NT, char* stage, const char* hb, const u32x4* pre = nullptr, const u32x4* pre_a = nullptr) {
  using C = GC<BN, BK>;
  constexpr bool BF32 = sizeof(TB) == 4;
  constexpr int ABYTES = AHB ? 0 : C::A_BYTES;
  constexpr int STG = ABYTES + C::B_BYTES;
  constexpr int NBR = BF32 ? BK * BN / 2048 : C::BP;
  const int tid = opaque_tid(), lane = tid & 63, wid = tid >> 6, r32 = lane & 31, hi = lane >> 5;
  const int wm = wid >> 2, wn = wid & 3;
  int ast0 = 0, ast1 = 0;
  if constexpr (!AHB) { ast0 = a_off<BK>(tid / C::CH, tid % C::CH); if constexpr (C::AP == 2) ast1 = a_off<BK>((512 + tid) / C::CH, (512 + tid) % C::CH); }
  const int row0 = wm * 64 + r32, row1 = row0 + 32;
  int bb0, bb1;
  if constexpr (DUAL) { bb0 = v_rd_base(lane) + (2 * wn) * 512; bb1 = v_rd_base(lane) + (8 + 2 * wn) * 512; }
  else { bb0 = v_rd_base(lane) + (wn * C::NB) * 512; bb1 = bb0; }
  const int sbase = (int)(uintptr_t)stage;
  bb0 += sbase + ABYTES; bb1 += sbase + ABYTES;

  struct Regs { u32x4 a[C::AP]; u32x4 b[NBR]; };
  auto gload = [&](Regs& R, int kt) {
    if constexpr (!AHB) {
      const char* ab = abase + (size_t)kt * (BK * 2);
      R.a[0] = *reinterpret_cast<const u32x4*>(ab + aoff0);
      if constexpr (C::AP == 2) R.a[1] = *reinterpret_cast<const u32x4*>(ab + aoff1);
    }
    const char* bb = bbase + (size_t)kt * BK * ldbB;
    if constexpr (BF32) {
#pragma unroll
      for (int i = 0; i < NBR; ++i) R.b[i] = *reinterpret_cast<const u32x4*>(bb + (size_t)i * ldbB + boff);
    } else {
#pragma unroll
      for (int i = 0; i < C::BP; ++i) R.b[i] = *reinterpret_cast<const u32x4*>(bb + (size_t)(i * C::RSTEP) * ldbB + boff);
    }
  };
  constexpr int NL = (AHB ? 0 : C::AP) + NBR;
  auto gload_one = [&](Regs& R, int kt, int l) {
    if (!AHB && l < C::AP) { const char* ab = abase + (size_t)kt * (BK * 2); R.a[l] = *reinterpret_cast<const u32x4*>(ab + (l == 0 ? aoff0 : aoff1)); }
    else { const int i = l - (AHB ? 0 : C::AP); const char* bb = bbase + (size_t)kt * BK * ldbB;
      if constexpr (BF32) R.b[i] = *reinterpret_cast<const u32x4*>(bb + (size_t)i * ldbB + boff);
      else R.b[i] = *reinterpret_cast<const u32x4*>(bb + (size_t)(i * C::RSTEP) * ldbB + boff); }
  };
  auto swrite_one = [&](Regs& R, int buf, int l) {
    char* s = stage + buf * STG;
    if (!AHB && l < C::AP) { *reinterpret_cast<u32x4*>(s + (l == 0 ? ast0 : ast1)) = R.a[l]; }
    else { const int i = l - (AHB ? 0 : C::AP);
      if constexpr (BF32) { const f32x4 v = *reinterpret_cast<f32x4*>(&R.b[i]);
        u32x2 w = {cvtpk(v[0], v[1]), cvtpk(v[2], v[3])};
        *reinterpret_cast<u32x2*>(s + ABYTES + b_st_off<BN>(bk0 + i, bc)) = w; }
      else *reinterpret_cast<u32x4*>(s + ABYTES + b_st_off<BN>(bk0 + i * C::RSTEP, bc)) = R.b[i]; }
  };
  auto swrite = [&](Regs& R, int buf) {
    char* s = stage + buf * STG;
    if constexpr (!AHB) {
      *reinterpret_cast<u32x4*>(s + ast0) = R.a[0];
      if constexpr (C::AP == 2) *reinterpret_cast<u32x4*>(s + ast1) = R.a[1];
    }
    if constexpr (BF32) {
#pragma unroll
      for (int i = 0; i < NBR; ++i) {
        const f32x4 v = *reinterpret_cast<f32x4*>(&R.b[i]);
        u32x2 w = {cvtpk(v[0], v[1]), cvtpk(v[2], v[3])};
        *reinterpret_cast<u32x2*>(s + ABYTES + b_st_off<BN>(bk0 + i, bc)) = w;
      }
    } else {
#pragma unroll
      for (int i = 0; i < C::BP; ++i) *reinterpret_cast<u32x4*>(s + ABYTES + b_st_off<BN>(bk0 + i * C::RSTEP, bc)) = R.b[i];
    }
  };
  auto compute = [&](int kt, int cur, Regs* Rn, int ktn) {
    const char* As = stage + cur * STG;
    const int b0 = bb0 + cur * STG, b1 = bb1 + cur * STG;
    auto mid = [&](int g) {
      if (Rn) {
#pragma unroll
        for (int l = 0; l < NL; ++l) if ((l & 3) == (g & 3)) swrite_one(*Rn, cur ^ 1, l);
#pragma unroll
        for (int l = 0; l < NL; ++l) if ((l & 3) == (g & 3)) gload_one(*Rn, ktn, l);
        SBAR();
      }
    };
#define KSTEP(S)                                                                                                   \
    do { bf16x8 a0, a1;                                                                                            \
      if constexpr (AHB) { const int ch = kt * (BK / 8) + (S) * 2 + hi;                                            \
        a0 = *reinterpret_cast<const bf16x8*>(hb + hb_off(row0, ch)); a1 = *reinterpret_cast<const bf16x8*>(hb + hb_off(row1, ch)); } \
      else { a0 = *reinterpret_cast<const bf16x8*>(As + a_off<BK>(row0, (S) * 2 + hi)); a1 = *reinterpret_cast<const bf16x8*>(As + a_off<BK>(row1, (S) * 2 + hi)); } \
      kstep<BN, S, SWAP, DUAL>(acc, a0, a1, b0, b1, mid); } while (0)
    KSTEP(0); KSTEP(1);
    if constexpr (BK == 64) { KSTEP(2); KSTEP(3); }
#undef KSTEP
  };
  auto compute_p = [&](int kt, int cur, Regs& R, const int mode) {
    const char* As = stage + cur * STG;
    const int b0 = bb0 + cur * STG, b1 = bb1 + cur * STG;
    auto trd = [&](int addr) { return __builtin_amdgcn_ds_read_tr16_b64_v4i16((LAS s16x4*)(size_t)(unsigned)addr); };
    auto rdA = [&](int S, bf16x8& a0, bf16x8& a1) {
      if constexpr (AHB) { const int ch = kt * (BK / 8) + S * 2 + hi;
        a0 = *reinterpret_cast<const bf16x8*>(hb + hb_off(row0, ch)); a1 = *reinterpret_cast<const bf16x8*>(hb + hb_off(row1, ch)); }
      else { a0 = *reinterpret_cast<const bf16x8*>(As + a_off<BK>(row0, S * 2 + hi)); a1 = *reinterpret_cast<const bf16x8*>(As + a_off<BK>(row1, S * 2 + hi)); }
    };
    auto rdB = [&](int S, int H, bf16x8& f0, bf16x8& f1) {
      constexpr int RS = (BN / 32) * 512;
      const int o0 = (2 * S) * RS, o1 = (2 * S + 1) * RS;
      const int base = (H == 0) ? b0 : (DUAL ? b1 : b0 + 1024);
      const s16x4 l0 = trd(base + o0), h0 = trd(base + o1), l1 = trd(base + o0 + 512), h1 = trd(base + o1 + 512);
      f0 = PKF(l0, h0); f1 = PKF(l1, h1);
    };
    auto mm = [&](int H, bf16x8 a0, bf16x8 a1, bf16x8 f0, bf16x8 f1) {
      if constexpr (SWAP) {
        acc[0][2 * H] = __builtin_amdgcn_mfma_f32_32x32x16_bf16(f0, a0, acc[0][2 * H], 0, 0, 0);
        acc[1][2 * H] = __builtin_amdgcn_mfma_f32_32x32x16_bf16(f0, a1, acc[1][2 * H], 0, 0, 0);
        acc[0][2 * H + 1] = __builtin_amdgcn_mfma_f32_32x32x16_bf16(f1, a0, acc[0][2 * H + 1], 0, 0, 0);
        acc[1][2 * H + 1] = __builtin_amdgcn_mfma_f32_32x32x16_bf16(f1, a1, acc[1][2 * H + 1], 0, 0, 0);
      } else {
        acc[0][2 * H] = __builtin_amdgcn_mfma_f32_32x32x16_bf16(a0, f0, acc[0][2 * H], 0, 0, 0);
        acc[1][2 * H] = __builtin_amdgcn_mfma_f32_32x32x16_bf16(a1, f0, acc[1][2 * H], 0, 0, 0);
        acc[0][2 * H + 1] = __builtin_amdgcn_mfma_f32_32x32x16_bf16(a0, f1, acc[0][2 * H + 1], 0, 0, 0);
        acc[1][2 * H + 1] = __builtin_amdgcn_mfma_f32_32x32x16_bf16(a1, f1, acc[1][2 * H + 1], 0, 0, 0);
      }
    };
    auto mid = [&](int g) {
      if (mode & 1) {
#pragma unroll
        for (int l = 0; l < NL; ++l) if ((l & 3) == g) swrite_one(R, cur ^ 1, l);
      }
      if (mode & 2) {
#pragma unroll
        for (int l = 0; l < NL; ++l) if ((l & 3) == g) gload_one(R, kt + 2, l);
      }
    };
    bf16x8 a0, a1, c0, c1, p0, p1, q0, q1;
    rdA(0, a0, a1); rdB(0, 0, p0, p1);
    rdB(0, 1, q0, q1); SBAR();
    mm(0, a0, a1, p0, p1); SBAR(); mid(0); SBAR();
    rdA(1, c0, c1); rdB(1, 0, p0, p1); SBAR();
    mm(1, a0, a1, q0, q1); SBAR(); mid(1); SBAR();
    rdB(1, 1, q0, q1); SBAR();
    mm(0, c0, c1, p0, p1); SBAR(); mid(2); SBAR();
    mm(1, c0, c1, q0, q1); SBAR(); mid(3); SBAR();
  };
  if constexpr (PF == 1) {
    Regs R;
    gload(R, 0);
    swrite(R, 0);
    if (NT > 1) gload(R, 1);
    __syncthreads();
#pragma unroll 1
    for (int kt = 0; kt < NT; ++kt) {
      const int cur = kt & 1;
      if (kt + 1 < NT) swrite(R, cur ^ 1);
      if (kt + 2 < NT) gload(R, kt + 2);
      compute(kt, cur, nullptr, 0);
      __syncthreads();
    }
  } else if constexpr (PF == 3) {
    static_assert(BN == 512 && BK == 32, "pipelined form");
    Regs R;
    if (pre) {
      static_assert(true, "");
#pragma unroll
      for (int i = 0; i < NBR; ++i) R.b[i] = pre[i];
      if constexpr (!AHB) { static_assert(AHB || C::AP == 1, "one A piece"); R.a[0] = pre_a[0]; }
    } else gload(R, 0);
    swrite(R, 0);
#pragma unroll
    for (int g = 0; g < 4; ++g) {
#pragma unroll
      for (int l = 0; l < NL; ++l) if ((l & 3) == g) { gload_one(R, 1, l); SBAR(); }
    }
    __syncthreads();
    int kt = 0;
#pragma unroll 1
    for (; kt + 2 < NT; ++kt) { compute_p(kt, kt & 1, R, 3); __syncthreads(); }
    compute_p(kt, kt & 1, R, 1); __syncthreads();
    ++kt;
    compute_p(kt, kt & 1, R, 0); __syncthreads();
  } else {
    Regs R0, R1;
    gload(R0, 0); gload(R1, 1);
    swrite(R0, 0);
    gload(R0, 2);
    __syncthreads();
    int kt = 0;
#pragma unroll 1
    for (; kt + 4 < NT; kt += 2) {
      compute(kt, 0, &R1, kt + 3); __syncthreads();
      compute(kt + 1, 1, &R0, kt + 4); __syncthreads();
    }
    swrite(R1, 1); gload(R1, kt + 3); compute(kt, 0, nullptr, 0); __syncthreads();
    swrite(R0, 0); compute(kt + 1, 1, nullptr, 0); __syncthreads();
    swrite(R1, 1); compute(kt + 2, 0, nullptr, 0); __syncthreads();
    compute(kt + 3, 1, nullptr, 0); __syncthreads();
  }
}

template <int MB, bool SWAP, bool AHB>
__device__ __forceinline__ void gemm_rs(f32x16 (&acc)[MB][2], const char* abase, unsigned aoff0, unsigned aoff1,
                                        const char* bstream, int KSS, int NT, char* stage, const char* hb, int rowbase) {
  const int tid = opaque_tid(), lane = tid & 63, r32 = lane & 31, hi = lane >> 5;
  const int ast0 = a_off<64>(tid >> 3, tid & 7), ast1 = a_off<64>(64 + (tid >> 3), tid & 7);
  const char* bl = bstream + lane * 16;
  bf16x8 bq[8][2];
  u32x4 ar0 = {0, 0, 0, 0}, ar1 = {0, 0, 0, 0};
  if constexpr (!AHB) { ar0 = *reinterpret_cast<const u32x4*>(abase + aoff0); ar1 = *reinterpret_cast<const u32x4*>(abase + aoff1); }
#pragma unroll
  for (int s2 = 0; s2 < 8; ++s2) { const int k0 = s2 < NT * 4 ? s2 : NT * 4 - 1; bq[s2][0] = *reinterpret_cast<const bf16x8*>(bl + (size_t)k0 * KSS); bq[s2][1] = *reinterpret_cast<const bf16x8*>(bl + (size_t)k0 * KSS + 1024); }
  if constexpr (!AHB) {
    *reinterpret_cast<u32x4*>(stage + ast0) = ar0; *reinterpret_cast<u32x4*>(stage + ast1) = ar1;
    ar0 = *reinterpret_cast<const u32x4*>(abase + (size_t)128 + aoff0); ar1 = *reinterpret_cast<const u32x4*>(abase + (size_t)128 + aoff1);
    __syncthreads();
  }
  const int lastks = NT * 4 - 1;
#pragma unroll 1
  for (int kt = 0; kt < NT; kt += 2) {
#pragma unroll
    for (int half = 0; half < 2; ++half) {
      const char* As = stage + half * 16384;
#pragma unroll
      for (int s2 = 0; s2 < 4; ++s2) {
        bf16x8 af[MB];
#pragma unroll
        for (int i = 0; i < MB; ++i) {
          if constexpr (AHB) af[i] = *reinterpret_cast<const bf16x8*>(hb + hb_off(rowbase + i * 32 + r32, ((kt + half) * 4 + s2) * 2 + hi));
          else af[i] = *reinterpret_cast<const bf16x8*>(As + a_off<64>(rowbase + i * 32 + r32, s2 * 2 + hi));
        }
        const bf16x8 b0 = bq[half * 4 + s2][0], b1 = bq[half * 4 + s2][1];
        int ksn = (kt + half + 2) * 4 + s2; ksn = ksn < lastks ? ksn : lastks;
        bq[half * 4 + s2][0] = *reinterpret_cast<const bf16x8*>(bl + (size_t)ksn * KSS); bq[half * 4 + s2][1] = *reinterpret_cast<const bf16x8*>(bl + (size_t)ksn * KSS + 1024);
#pragma unroll
        for (int i = 0; i < MB; ++i) {
          if constexpr (SWAP) {
            acc[i][0] = __builtin_amdgcn_mfma_f32_32x32x16_bf16(b0, af[i], acc[i][0], 0, 0, 0);
            acc[i][1] = __builtin_amdgcn_mfma_f32_32x32x16_bf16(b1, af[i], acc[i][1], 0, 0, 0);
          } else {
            acc[i][0] = __builtin_amdgcn_mfma_f32_32x32x16_bf16(af[i], b0, acc[i][0], 0, 0, 0);
            acc[i][1] = __builtin_amdgcn_mfma_f32_32x32x16_bf16(af[i], b1, acc[i][1], 0, 0, 0);
          }
        }
      }
      if constexpr (!AHB) {
        char* sn = stage + (half ^ 1) * 16384;
        *reinterpret_cast<u32x4*>(sn + ast0) = ar0; *reinterpret_cast<u32x4*>(sn + ast1) = ar1;
        const int k2 = kt + half + 2 < NT ? kt + half + 2 : NT - 1;
        ar0 = *reinterpret_cast<const u32x4*>(abase + (size_t)k2 * 128 + aoff0); ar1 = *reinterpret_cast<const u32x4*>(abase + (size_t)k2 * 128 + aoff1);
        __syncthreads();
      }
    }
  }
}

__device__ __forceinline__ unsigned pack_pair(float v0, float v1, int odd) {
  const float send = odd ? v0 : v1;
  const float recv = __shfl_xor(send, 1);
  const float lo = odd ? recv : v0, hh = odd ? v1 : recv;
  return cvtpk(lo, hh);
}

__device__ __forceinline__ void cvt_range(const float* __restrict__ src, bf16_t* __restrict__ dst, size_t n8, size_t gtid, size_t gsz) {
  for (size_t i = gtid; i < n8; i += gsz) {
    const f32x4 a = *reinterpret_cast<const f32x4*>(src + i * 8), b = *reinterpret_cast<const f32x4*>(src + i * 8 + 4);
    *reinterpret_cast<bf16x8*>(dst + i * 8) = cvt8(a, b);
  }
}
__device__ __forceinline__ void pretile_dense(const float* __restrict__ src, int ld, int Nvalid, bf16_t* __restrict__ dst, int K, int N) {
  const int tid_o = opaque_tid(), lane = tid_o & 63, wv = blockIdx.x * 8 + (tid_o >> 6), nwv = gridDim.x * 8;
  const int nfr = (K / 16) * (N / 32);
  for (int f = wv; f < nfr; f += nwv) {
    const int ks = f / (N / 32), nb = f % (N / 32);
    const int n = nb * 32 + (lane & 31), k0 = ks * 16 + (lane >> 5) * 8;
    float v[8];
#pragma unroll
    for (int jj = 0; jj < 8; ++jj) v[jj] = n < Nvalid ? src[(size_t)(k0 + jj) * ld + n] : 0.f;
    u32x4 o = {cvtpk(v[0], v[1]), cvtpk(v[2], v[3]), cvtpk(v[4], v[5]), cvtpk(v[6], v[7])};
    *reinterpret_cast<u32x4*>((char*)dst + (size_t)f * 1024 + lane * 16) = o;
  }
}
__device__ __forceinline__ void phase_prologue(const Params& p, char* lds) {
  const size_t gtid = (size_t)blockIdx.x * NTHR + threadIdx.x, gsz = (size_t)gridDim.x * NTHR;
  char* ws = p.ws;
  auto small_jobs = [&]() {
  if (blockIdx.x == 0) { ((int*)(ws + OFF_CNTP))[threadIdx.x * CNT_STRIDE] = 0; }
  cvt_range(p.pool_w, (bf16_t*)(ws + OFF_WPOOL), 4 * 256 * 256 / 8, gtid, gsz);
  cvt_range(p.router_w, (bf16_t*)(ws + OFF_WR), 2 * DM * NEXP / 8, gtid, gsz);
  pretile_dense(p.w_uq, 1536, 1536, (bf16_t*)(ws + OFF_WUQ), QL, 1536);
  pretile_dense(p.w_uk, 1024, 1024, (bf16_t*)(ws + OFF_WUK), KVL, 1024);
  pretile_dense(p.w_uv, 1024, 1024, (bf16_t*)(ws + OFF_WUV), KVL, 1024);
  pretile_dense(p.w_o, DM, DM, (bf16_t*)(ws + OFF_WO), DM, DM);
  {
    bf16_t* wa = (bf16_t*)(ws + OFF_WA);
    for (size_t i = gtid; i < (size_t)DM * WA_NP / 8; i += gsz) {
      const int k = (int)(i / (WA_NP / 8)), n = (int)(i % (WA_NP / 8)) * 8;
      bf16x8 v = {0, 0, 0, 0, 0, 0, 0, 0};
      if (n < WA_N) { const float* s = p.w_a + (size_t)k * WA_N + n; v = cvt8(*reinterpret_cast<const f32x4*>(s), *reinterpret_cast<const f32x4*>(s + 4)); }
      *reinterpret_cast<bf16x8*>(wa + (size_t)k * WA_NP + n) = v;
    }
  }
  {
    float* rc = (float*)(ws + OFF_ROPE); float* rs = rc + SEQ * 32;
    for (size_t i = gtid; i < (size_t)SEQ * 32; i += gsz) {
      const int pos = (int)(i >> 5), j = (int)(i & 31);
      const double inv = exp(-(double)(2 * j) / 64.0 * 9.210340371976184);
      const double ang = (double)pos * inv;
      rc[i] = (float)cos(ang); rs[i] = (float)sin(ang);
    }
  }
  };
  {
    bf16_t* pooled = (bf16_t*)(ws + OFF_POOLED);
    float* tile = reinterpret_cast<float*>(lds);
    const int tid = threadIdx.x, cq = tid & 127, rg = tid >> 7;
    const int nit = ((NTOK / 32 - (int)blockIdx.x + (int)gridDim.x - 1) / (int)gridDim.x) * 2;
    f32x4 pre[12];
    auto fetch = [&](int it) {
      const int ch = blockIdx.x + (it >> 1) * gridDim.x, hf = it & 1, t0 = ch * 32, s0 = t0 & (SEQ - 1);
      const float* xb = p.x + (size_t)(t0 - s0) * DM;
#pragma unroll
      for (int i = 0; i < 12; ++i) {
        const int q = i * 512 + tid, rl = q >> 7, c4 = (q & 127) * 4, r = s0 - 8 + rl;
        if (r >= 0 && r < SEQ) pre[i] = *reinterpret_cast<const f32x4*>(xb + (size_t)r * DM + hf * 512 + c4);
      }
    };
    if (nit > 0) fetch(0);
    small_jobs();
    for (int it = 0; it < nit; ++it) {
      const int ch = blockIdx.x + (it >> 1) * gridDim.x, hf = it & 1, t0 = ch * 32, s0 = t0 & (SEQ - 1);
      {
        __syncthreads();
#pragma unroll
        for (int i = 0; i < 12; ++i) {
          const int q = i * 512 + tid, rl = q >> 7, c4 = (q & 127) * 4, r = s0 - 8 + rl;
          if (r >= 0 && r < SEQ) *reinterpret_cast<f32x4*>(tile + rl * 512 + c4) = pre[i];
        }
        __syncthreads();
        if (it + 1 < nit) fetch(it + 1);
        const int c = cq * 4, g = (hf * 512 + c) >> 8, hw = 1 << g;
#pragma unroll 1
        for (int rr = 0; rr < 8; ++rr) {
          const int t = s0 + rg * 8 + rr;
          const int lo = t - hw < 0 ? 0 : t - hw, hi = t + hw > SEQ ? SEQ : t + hw;
          f32x4 sum = {0.f, 0.f, 0.f, 0.f};
          for (int r = lo; r < hi; ++r) sum += *reinterpret_cast<const f32x4*>(tile + (r - s0 + 8) * 512 + c);
          const f32x4 xv = *reinterpret_cast<const f32x4*>(tile + (t - s0 + 8) * 512 + c);
          const float inv = 1.f / (float)(hi - lo);
          u32x2 w = {cvtpk(sum[0] * inv - xv[0], sum[1] * inv - xv[1]), cvtpk(sum[2] * inv - xv[2], sum[3] * inv - xv[3])};
          *reinterpret_cast<u32x2*>(pooled + (size_t)(t0 + rg * 8 + rr) * DM + hf * 512 + c) = w;
        }
      }
    }
    __syncthreads();
  }
}

constexpr int GBN = 256, GBK = 64;
enum { EPI_POOL = 0, EPI_F32 = 1, EPI_Q = 2, EPI_K = 3, EPI_V = 4, EPI_WO = 5 };


__device__ __forceinline__ void acc_bf16x8(f32x4& lo, f32x4& hi4, u32x4 w) {
  lo[0] += __uint_as_float(w[0] << 16); lo[1] += __uint_as_float(w[0] & 0xffff0000u); lo[2] += __uint_as_float(w[1] << 16); lo[3] += __uint_as_float(w[1] & 0xffff0000u);
  hi4[0] += __uint_as_float(w[2] << 16); hi4[1] += __uint_as_float(w[2] & 0xffff0000u); hi4[2] += __uint_as_float(w[3] << 16); hi4[3] += __uint_as_float(w[3] & 0xffff0000u);
}
constexpr int EPW = 68;
constexpr int EP_WAVE_BYTES = 32 * EPW * 4;
__device__ __forceinline__ void epi_to_lds(const f32x16& a0, const f32x16& a1, float* w, int r32, int hi) {
#pragma unroll
  for (int r = 0; r < 16; ++r) { w[crow(r, hi) * EPW + r32] = a0[r]; w[crow(r, hi) * EPW + 32 + r32] = a1[r]; }
}
template <int EPI>
__device__ __forceinline__ void dense_epilogue(const Params& p, char* lds, f32x16& a0, f32x16& a1, int mb, int nb, float* outf, bf16_t* outb, int ldo, int aux) {
  const int tid = opaque_tid(), lane = tid & 63, wid = tid >> 6, r32 = lane & 31, hi = lane >> 5;
  float* w = reinterpret_cast<float*>(lds + wid * EP_WAVE_BYTES);
  if constexpr (EPI == EPI_Q) {
    if (((nb >> 6) % 3) == 2) {
      const float* rc = (const float*)(p.ws + OFF_ROPE); const float* rs = rc + SEQ * 32;
#pragma unroll
      for (int r = 0; r < 16; ++r) {
        const int pos = (mb + crow(r, hi)) & (SEQ - 1);
        const float c = rc[pos * 32 + r32], sn = rs[pos * 32 + r32];
        const float x1 = a0[r], x2 = a1[r];
        a0[r] = x1 * c - x2 * sn; a1[r] = x1 * sn + x2 * c;
      }
    }
  }
  epi_to_lds(a0, a1, w, r32, hi);
  if constexpr (EPI == EPI_POOL || EPI == EPI_WO) {
#pragma unroll
    for (int it = 0; it < 4; ++it) {
      const int idx = it * 64 + lane, row = idx >> 3, c8 = (idx & 7) * 8;
      f32x4 v0 = *reinterpret_cast<const f32x4*>(w + row * EPW + c8), v1 = *reinterpret_cast<const f32x4*>(w + row * EPW + c8 + 4);
      size_t o;
      if constexpr (EPI == EPI_POOL) {
        const int n = aux * 256 + nb + c8; o = (size_t)(mb + row) * DM + n;
        v0 = (v0 + *reinterpret_cast<const f32x4*>(p.pool_b + n)) * *reinterpret_cast<const f32x4*>(p.pool_scale + n) + *reinterpret_cast<const f32x4*>(p.x + o) * ALPHA;
        v1 = (v1 + *reinterpret_cast<const f32x4*>(p.pool_b + n + 4)) * *reinterpret_cast<const f32x4*>(p.pool_scale + n + 4) + *reinterpret_cast<const f32x4*>(p.x + o + 4) * ALPHA;
      } else {
        o = (size_t)(mb + row) * DM + nb + c8;
        f32x4 h0 = {0.f, 0.f, 0.f, 0.f}, h1 = {0.f, 0.f, 0.f, 0.f};
        acc_bf16x8(h0, h1, *reinterpret_cast<const u32x4*>((const bf16_t*)(p.ws + OFF_H1B) + o));
        v0 += h0 * ALPHA; v1 += h1 * ALPHA;
      }
      *reinterpret_cast<bf16x8*>(outb + o) = cvt8(v0, v1);
    }
  } else if constexpr (EPI == EPI_F32) {
#pragma unroll
    for (int it = 0; it < 8; ++it) {
      const int idx = it * 64 + lane, row = idx >> 4, c4 = (idx & 15) * 4;
      f32x4 v = *reinterpret_cast<const f32x4*>(w + row * EPW + c4);
      *reinterpret_cast<f32x4*>(outf + (size_t)(mb + row) * ldo + nb + c4) = v;
    }
  } else {
    int colbase;
    if constexpr (EPI == EPI_K) colbase = (nb >> 7) * 192 + (nb & 127); else colbase = nb;
#pragma unroll
    for (int it = 0; it < 4; ++it) {
      const int idx = it * 64 + lane, row = idx >> 3, c8 = (idx & 7) * 8;
      const f32x4 v0 = *reinterpret_cast<const f32x4*>(w + row * EPW + c8), v1 = *reinterpret_cast<const f32x4*>(w + row * EPW + c8 + 4);
      *reinterpret_cast<bf16x8*>(outb + (size_t)(mb + row) * ldo + colbase + c8) = cvt8(v0, v1);
    }
  }
}
template <int EPI>
__device__ __forceinline__ void dense_tile(const Params& p, char* lds, const bf16_t* A, int lda, const bf16_t* B, int ldb, int K, int m0, int n0,
                                           float* outf, bf16_t* outb, int ldo, int aux) {
  using C = GC<GBN, GBK>;
  int tid = opaque_tid(), lane = tid & 63, wid = tid >> 6, r32 = lane & 31, hi = lane >> 5, wm = wid >> 2, wn = wid & 3;
  f32x16 acc[2][2];
#pragma unroll
  for (int i = 0; i < 2; ++i)
#pragma unroll
    for (int j = 0; j < 2; ++j) acc[i][j] = f32x16{};
  const char* abase = (const char*)(A + (size_t)m0 * lda);
  const unsigned aoff0 = (unsigned)(((tid >> 3) * lda + (tid & 7) * 8) * 2), aoff1 = aoff0 + (unsigned)(64 * lda * 2);
  const int bk0 = tid / C::CPR, bc = (tid % C::CPR) * 8;
  __syncthreads();
  gemm_core<GBN, GBK, false, false, false, bf16_t>(acc, abase, aoff0, aoff1, (const char*)(B + n0), (unsigned)((bk0 * ldb + bc) * 2), (unsigned)(ldb * 2), bk0, bc, K / GBK, lds, nullptr);
  tid = opaque_tid(); lane = tid & 63; wid = tid >> 6; r32 = lane & 31; hi = lane >> 5; wm = wid >> 2; wn = wid & 3;
  const int nb = n0 + wn * 64;
#pragma unroll
  for (int i = 0; i < 2; ++i) dense_epilogue<EPI>(p, lds, acc[i][0], acc[i][1], m0 + wm * 64 + i * 32, nb, outf, outb, ldo, aux);
}

template <int EPI>
__device__ __forceinline__ void dense_tile512(const Params& p, char* lds, const bf16_t* A, int lda, const bf16_t* Bt, int Ncols, int K, int m0, int n0,
                                           float* outf, bf16_t* outb, int ldo, int aux) {
  using C = GC<GBN, GBK>;
  int tid = opaque_tid(), lane = tid & 63, wid = tid >> 6, r32 = lane & 31, hi = lane >> 5, wm = wid >> 2, wn = wid & 3;
  f32x16 acc[4][2];
#pragma unroll
  for (int i = 0; i < 4; ++i)
#pragma unroll
    for (int j = 0; j < 2; ++j) acc[i][j] = f32x16{};
  const char* abase = (const char*)(A + (size_t)m0 * lda);
  const unsigned aoff0 = (unsigned)(((tid >> 3) * lda + (tid & 7) * 8) * 2), aoff1 = aoff0 + (unsigned)(64 * lda * 2);
  const int wu = __builtin_amdgcn_readfirstlane(wid);
  __syncthreads();
  gemm_rs<4, false, false>(acc, abase, aoff0, aoff1, (const char*)Bt + (size_t)((n0 >> 6) + wu) * 2048, (Ncols >> 6) * 2048, K / 64, lds, nullptr, 0);
  tid = opaque_tid(); lane = tid & 63; wid = tid >> 6; r32 = lane & 31; hi = lane >> 5; wm = wid >> 2; wn = wid & 3;
  const int nb = n0 + wid * 64;
#pragma unroll
  for (int i = 0; i < 4; ++i) dense_epilogue<EPI>(p, lds, acc[i][0], acc[i][1], m0 + i * 32, nb, outf, outb, ldo, aux);
}

__device__ __forceinline__ void phase_pool_gemm(const Params& p, char* lds) {
  const bf16_t* pooled = (const bf16_t*)(p.ws + OFF_POOLED); const bf16_t* wp = (const bf16_t*)(p.ws + OFF_WPOOL);
  bf16_t* z = (bf16_t*)(p.ws + OFF_Z);
  for (int u = blockIdx.x; u < 128 * 4; u += gridDim.x) {
    const int mt = u >> 2, g = u & 3;
    dense_tile<EPI_POOL>(p, lds, pooled + g * 256, DM, wp + (size_t)g * 65536, 256, 256, mt * 128, 0, nullptr, z, DM, g);
  }
}
__device__ __forceinline__ void phase_router_gemm(const Params& p, char* lds, int layer) {
  const bf16_t* hb = (const bf16_t*)(p.ws + (layer == 0 ? OFF_H0B : OFF_H0B));
  const bf16_t* wr = (const bf16_t*)(p.ws + OFF_WR) + (size_t)layer * DM * NEXP;
  float* lg = (float*)(p.ws + OFF_LOGIT);
  float* lg1 = (float*)(p.ws + OFF_H1F);
  for (int u = blockIdx.x; u < 256; u += gridDim.x) { const int mt = u >> 1, kh = u & 1;
    dense_tile<EPI_F32>(p, lds, hb + kh * (DM / 2), DM, wr + (size_t)kh * (DM / 2) * NEXP, NEXP, DM / 2, mt * 128, 0, kh ? lg1 : lg, nullptr, NEXP, 0); }
}
__device__ __forceinline__ void phase_wa_gemm(const Params& p, char* lds) {
  const bf16_t* hb = (const bf16_t*)(p.ws + OFF_H1B); const bf16_t* wa = (const bf16_t*)(p.ws + OFF_WA);
  float* ab = (float*)(p.ws + OFF_ABUF);
  for (int u = blockIdx.x; u < 128 * 3; u += gridDim.x) { const int mt = u / 3, nt = u % 3;
    dense_tile<EPI_F32>(p, lds, hb, DM, wa, WA_NP, DM, mt * 128, nt * 256, ab, nullptr, WA_NP, 0); }
}
__device__ __forceinline__ void phase_qkv_gemm(const Params& p, char* lds) {
  const bf16_t* ql = (const bf16_t*)(p.ws + OFF_QLAT); const bf16_t* kvl = (const bf16_t*)(p.ws + OFF_KVLAT);
  const bf16_t* wuq = (const bf16_t*)(p.ws + OFF_WUQ); const bf16_t* wuk = (const bf16_t*)(p.ws + OFF_WUK); const bf16_t* wuv = (const bf16_t*)(p.ws + OFF_WUV);
  bf16_t* Q = (bf16_t*)(p.ws + OFF_Q); bf16_t* Kb = (bf16_t*)(p.ws + OFF_K); bf16_t* V = (bf16_t*)(p.ws + OFF_V);
  for (int u = blockIdx.x; u < 128 * 7; u += gridDim.x) {
    const int mt = u / 7, s = u % 7;
    if (s < 3) dense_tile512<EPI_Q>(p, lds, ql, QL, wuq, 1536, QL, mt * 128, s * 512, nullptr, Q, 1536, 0);
    else if (s < 5) dense_tile512<EPI_K>(p, lds, kvl, KVL, wuk, 1024, KVL, mt * 128, (s - 3) * 512, nullptr, Kb, 1536, 0);
    else dense_tile512<EPI_V>(p, lds, kvl, KVL, wuv, 1024, KVL, mt * 128, (s - 5) * 512, nullptr, V, 1024, 0);
  }
}
__device__ __forceinline__ void phase_wo_gemm(const Params& p, char* lds) {
  const bf16_t* O = (const bf16_t*)(p.ws + OFF_O); const bf16_t* wo = (const bf16_t*)(p.ws + OFF_WO);
  bf16_t* z = (bf16_t*)(p.ws + OFF_Z);
  for (int u = blockIdx.x; u < 128 * 2; u += gridDim.x) { const int mt = u >> 1, nt = u & 1;
    dense_tile512<EPI_WO>(p, lds, O, DM, wo, DM, DM, mt * 128, nt * 512, nullptr, z, DM, 0); }
}

__device__ __forceinline__ int lcol(int lane, int i) { return 512 * (i >> 1) + 8 * lane + 4 * (i & 1); }
__device__ __forceinline__ void ln_row_store(f32x4 (&v)[4], const float* g, const float* b, float* of, bf16_t* ob, int lane) {
  float s = 0.f;
#pragma unroll
  for (int i = 0; i < 4; ++i) s += v[i][0] + v[i][1] + v[i][2] + v[i][3];
  const float mu = wave_sum(s) * (1.f / DM);
  float q = 0.f;
#pragma unroll
  for (int i = 0; i < 4; ++i) { v[i] -= mu; q += v[i][0] * v[i][0] + v[i][1] * v[i][1] + v[i][2] * v[i][2] + v[i][3] * v[i][3]; }
  const float rstd = rsqrtf(wave_sum(q) * (1.f / DM) + LN_EPS);
#pragma unroll
  for (int i = 0; i < 4; ++i) {
    const int c = lcol(lane, i);
    const f32x4 gg = *reinterpret_cast<const f32x4*>(g + c), bb = *reinterpret_cast<const f32x4*>(b + c);
    v[i] = v[i] * rstd * gg + bb;
    if (of) *reinterpret_cast<f32x4*>(of + c) = v[i];
  }
  if (ob) {
    *reinterpret_cast<bf16x8*>(ob + lcol(lane, 0)) = cvt8(v[0], v[1]);
    *reinterpret_cast<bf16x8*>(ob + lcol(lane, 2)) = cvt8(v[2], v[3]);
  }
}
__device__ __forceinline__ void phase_ln(const Params& p, const float* g, const float* b, float* of, bf16_t* ob) {
  const bf16_t* z = (const bf16_t*)(p.ws + OFF_Z);
  const int tid_o = opaque_tid(), lane = tid_o & 63, wv = blockIdx.x * 8 + (tid_o >> 6);
  for (int t = wv; t < NTOK; t += gridDim.x * 8) {
    f32x4 v[4];
#pragma unroll
    for (int i = 0; i < 4; ++i) v[i] = f32x4{0.f, 0.f, 0.f, 0.f};
#pragma unroll
    for (int ch = 0; ch < 2; ++ch) acc_bf16x8(v[2 * ch], v[2 * ch + 1], *reinterpret_cast<const u32x4*>(z + (size_t)t * DM + lcol(lane, 2 * ch)));
    ln_row_store(v, g, b, of ? of + (size_t)t * DM : nullptr, ob ? ob + (size_t)t * DM : nullptr, lane);
  }
}
__device__ __forceinline__ void phase_combine_ln(const Params& p, const bf16_t* hres, const float* g, const float* b, float* of, bf16_t* ob) {
  const bf16_t* Y = (const bf16_t*)(p.ws + OFF_Y); const bf16_t* Ysh = (const bf16_t*)(p.ws + OFF_YSH);
  const int tid_o = opaque_tid(), lane = tid_o & 63, wv = blockIdx.x * 8 + (tid_o >> 6);
  for (int t = wv; t < NTOK; t += gridDim.x * 8) {
    f32x4 v[4];
#pragma unroll
    for (int i = 0; i < 4; ++i) v[i] = f32x4{0.f, 0.f, 0.f, 0.f};
#pragma unroll
    for (int ch = 0; ch < 2; ++ch) {
      const int c = lcol(lane, 2 * ch);
      acc_bf16x8(v[2 * ch], v[2 * ch + 1], *reinterpret_cast<const u32x4*>(hres + (size_t)t * DM + c));
      v[2 * ch] *= ALPHA; v[2 * ch + 1] *= ALPHA;
      acc_bf16x8(v[2 * ch], v[2 * ch + 1], __builtin_nontemporal_load(reinterpret_cast<const u32x4*>(Ysh + (size_t)t * DM + c)));
#pragma unroll
      for (int k = 0; k < TOPK; ++k) acc_bf16x8(v[2 * ch], v[2 * ch + 1], __builtin_nontemporal_load(reinterpret_cast<const u32x4*>(Y + ((size_t)t * TOPK + k) * DM + c)));
    }
    ln_row_store(v, g, b, of ? of + (size_t)t * DM : nullptr, ob ? ob + (size_t)t * DM : nullptr, lane);
  }
}

__device__ __forceinline__ void phase_route(const Params& p, char* lds, int layer) {
  const float* lg = (const float*)(p.ws + OFF_LOGIT); const float* lg1 = (const float*)(p.ws + OFF_H1F);
  const float* rb = p.router_b + layer * NEXP;
  int* cnt = (int*)(p.ws + OFF_CNTP) + layer * NEXP * CNT_STRIDE;
  int* list = (int*)(p.ws + OFF_LIST);
  float* gate = (float*)(p.ws + OFF_GATE);
  int* texp = (int*)(p.ws + OFF_TEXP);
  int* hist = (int*)lds; int* base = hist + NEXP; int* s_e = base + NEXP; int* s_pos = s_e + 512; float* s_g = (float*)(s_pos + 512);
  float* glist = (float*)(p.ws + OFF_GLIST);
  const int tid = threadIdx.x, lane = tid & 63, wid = tid >> 6;
  const f32x4 bias = *reinterpret_cast<const f32x4*>(rb + lane * 4);
  const int per = (NTOK + (int)gridDim.x - 1) / (int)gridDim.x;
  const int tb0 = blockIdx.x * per, tb1 = tb0 + per < NTOK ? tb0 + per : NTOK;
  for (int c0 = tb0; c0 < tb1; c0 += 64) {
    __syncthreads();
    if (tid < NEXP) hist[tid] = 0;
    __syncthreads();
    f32x4 zz[8];
#pragma unroll
    for (int j = 0; j < 8; ++j) { const int t = c0 + wid * 8 + j; const size_t o = (size_t)(t < tb1 ? t : tb1 - 1) * NEXP + lane * 4; zz[j] = *reinterpret_cast<const f32x4*>(lg + o) + *reinterpret_cast<const f32x4*>(lg1 + o); }
#pragma unroll
    for (int jp = 0; jp < 4; ++jp) {
      float sc[2][4], bv[2][4];
      int tl[2], tt[2]; bool ok[2];
#pragma unroll
      for (int u = 0; u < 2; ++u) {
        tl[u] = wid * 8 + 2 * jp + u; tt[u] = c0 + tl[u]; ok[u] = tt[u] < tb1;
        const f32x4 z = zz[2 * jp + u];
#pragma unroll
        for (int k = 0; k < 4; ++k) { sc[u][k] = 1.f / (1.f + __expf(-z[k])); bv[u][k] = sc[u][k] + bias[k]; }
      }
      const int grp = lane >> 3;
#pragma unroll
      for (int u = 0; u < 2; ++u) {
        float m1 = fmaxf(bv[u][0], bv[u][1]), m2 = fminf(bv[u][0], bv[u][1]);
#pragma unroll
        for (int k = 2; k < 4; ++k) { const float a = bv[u][k]; const float n1 = fmaxf(m1, a); m2 = fmaxf(fminf(m1, a), m2); m1 = n1; }
#define TOP2_STEP(CTRL) { const float o1 = dppf<CTRL>(m1), o2 = dppf<CTRL>(m2); const float n1 = fmaxf(m1, o1); m2 = fmaxf(fminf(m1, o1), fmaxf(m2, o2)); m1 = n1; }
        TOP2_STEP(DPP_XOR1) TOP2_STEP(DPP_XOR2) TOP2_STEP(DPP_HALF_MIRROR)
#undef TOP2_STEP
        const float gs = m1 + m2;
        int rank = 0;
#pragma unroll
        for (int g2 = 0; g2 < 8; ++g2) { const float og = rdlane(gs, g2 * 8); rank += (og > gs || (og == gs && g2 < grp)) ? 1 : 0; }
        const bool sel = rank < 4;
#pragma unroll
        for (int k = 0; k < 4; ++k) if (!sel) bv[u][k] = -INFINITY;
      }
      int my_e[2] = {0, 0}; float my_s[2] = {0.f, 0.f}, ssum[2] = {0.f, 0.f};
#pragma unroll 1
      for (int kk = 0; kk < TOPK; ++kk) {
#pragma unroll
        for (int u = 0; u < 2; ++u) {
          float lb = bv[u][0]; int li = 0;
#pragma unroll
          for (int k = 1; k < 4; ++k) if (bv[u][k] > lb) { lb = bv[u][k]; li = k; }
          const float mx = wave_max(lb);
          const unsigned long long bal = __ballot(lb == mx);
          const int wl = __builtin_amdgcn_readfirstlane(__ffsll((long long)bal) - 1);
          const int we = __builtin_amdgcn_readlane(lane * 4 + li, wl);
          float ws_ = sc[u][0];
#pragma unroll
          for (int k = 1; k < 4; ++k) if (li == k) ws_ = sc[u][k];
          ws_ = rdlane(ws_, wl);
#pragma unroll
          for (int k = 0; k < 4; ++k) if (lane == wl && li == k) bv[u][k] = -INFINITY;
          ssum[u] += ws_;
          if (lane == kk) { my_e[u] = we; my_s[u] = ws_; }
        }
      }
#pragma unroll
      for (int u = 0; u < 2; ++u) {
        if (ok[u] && lane < TOPK) {
          s_e[tl[u] * 8 + lane] = my_e[u];
          s_pos[tl[u] * 8 + lane] = atomicAdd(&hist[my_e[u]], 1);
          const float gv = my_s[u] / ssum[u] * 2.5f;
          gate[tt[u] * TOPK + lane] = gv; s_g[tl[u] * 8 + lane] = gv;
          texp[tt[u] * TOPK + lane] = my_e[u];
        }
      }
    }
    __syncthreads();
    if (tid < NEXP) { const int h = hist[tid]; base[tid] = h ? atomicAdd(&cnt[tid * CNT_STRIDE], h) : 0; }
    __syncthreads();
    {
      const int tl = tid >> 3, t = c0 + tl;
      if (t < tb1) { const int e = s_e[tid]; const size_t li = (size_t)e * NTOK + base[e] + s_pos[tid]; list[li] = t * TOPK + (tid & 7); glist[li] = s_g[tid]; }
    }
  }
}

__device__ __forceinline__ void phase_mla_rows(const Params& p) {
  const float* ab = (const float*)(p.ws + OFF_ABUF);
  bf16_t* ql = (bf16_t*)(p.ws + OFF_QLAT); bf16_t* kvl = (bf16_t*)(p.ws + OFF_KVLAT); bf16_t* Kb = (bf16_t*)(p.ws + OFF_K);
  const float* rc = (const float*)(p.ws + OFF_ROPE); const float* rs = rc + SEQ * 32;
  const int tid_o = opaque_tid(), lane = tid_o & 63, wv = blockIdx.x * 8 + (tid_o >> 6);
  for (int t = wv; t < NTOK; t += gridDim.x * 8) {
    const float* a = ab + (size_t)t * WA_NP;
    float q[6], kv[4];
    float sq = 0.f, sk = 0.f;
#pragma unroll
    for (int i = 0; i < 6; ++i) { q[i] = a[lane + 64 * i]; sq += q[i] * q[i]; }
#pragma unroll
    for (int i = 0; i < 4; ++i) { kv[i] = a[QL + lane + 64 * i]; sk += kv[i] * kv[i]; }
    const float rq = rsqrtf(wave_sum(sq) * (1.f / QL) + RMS_EPS), rk = rsqrtf(wave_sum(sk) * (1.f / KVL) + RMS_EPS);
#pragma unroll
    for (int i = 0; i < 6; ++i) ql[(size_t)t * QL + lane + 64 * i] = f2bf(q[i] * rq * p.qn_g[lane + 64 * i]);
#pragma unroll
    for (int i = 0; i < 4; ++i) kvl[(size_t)t * KVL + lane + 64 * i] = f2bf(kv[i] * rk * p.kvn_g[lane + 64 * i]);
    const float mine = a[QL + KVL + lane];
    const float other = __shfl_xor(mine, 32);
    const int pos = t & (SEQ - 1), j = lane & 31;
    const float c = rc[pos * 32 + j], s = rs[pos * 32 + j];
    const float o = lane < 32 ? mine * c - other * s : other * s + mine * c;
    const bf16_t ob = f2bf(o);
#pragma unroll
    for (int h = 0; h < NH; ++h) Kb[(size_t)t * 1536 + h * DQK + DNOPE + lane] = ob;
  }
}

#ifndef MOE_PF
#define MOE_PF 3
#endif
#ifndef MOE_STAGGER
#define MOE_STAGGER 0
#endif
#ifndef MOE_ROUND_SYNC
#define MOE_ROUND_SYNC 0
#endif
constexpr int MOE_STAGE = 2 * GC<512, 32>::STAGE;
constexpr int MOE_HB = MOE_STAGE;
constexpr int MOE_META = MOE_HB + 65536;
constexpr int LDS_BYTES = MOE_META + 128 * 4 + 128 * 4 + 260 * 4 + 1024;
static_assert(LDS_BYTES <= 160 * 1024, "LDS");

__device__ __forceinline__ void phase_moe(const Params& p, char* lds, int layer) {
  using C = GC<512, 32>;
  int tid = threadIdx.x, lane = tid & 63, wid = tid >> 6, r32 = lane & 31, hi = lane >> 5, wm = wid >> 2, wn = wid & 3;
  const int* cnt = (const int*)(p.ws + OFF_CNTP) + layer * NEXP * CNT_STRIDE;
  const int* list = (const int*)(p.ws + OFF_LIST);
  const float* glist = (const float*)(p.ws + OFF_GLIST);
  const bf16_t* hin = (const bf16_t*)(p.ws + (layer == 0 ? OFF_H0B : OFF_H0B));
  bf16_t* Y = (bf16_t*)(p.ws + OFF_Y); bf16_t* Ysh = (bf16_t*)(p.ws + OFF_YSH);
  int* s_slot = (int*)(lds + MOE_META); float* s_gate = (float*)(lds + MOE_META + 512); int* s_pre = (int*)(lds + MOE_META + 1024);
  int* const s_slot0 = s_slot; float* const s_gate0 = s_gate; int* const s_slot1 = (int*)(lds + MOE_META + 1024 + 260 * 4); float* const s_gate1 = (float*)(s_slot1 + 128);
  char* hb = lds + MOE_HB;
  if (tid < 64) {
    int run = 0;
    for (int c0 = 0; c0 < 256; c0 += 64) {
      const int e = c0 + tid; const int tl = (cnt[e * CNT_STRIDE] + 127) >> 7;
      int incl = tl;
#pragma unroll
      for (int o = 1; o < 64; o <<= 1) { const int v = __shfl_up(incl, o); if (lane >= o) incl += v; }
      s_pre[e] = run + incl - tl;
      run += __shfl(incl, 63);
    }
    if (tid == 0) { s_pre[256] = run; s_pre[257] = run + 128; }
  }
  __syncthreads();
  const int U = __builtin_amdgcn_readfirstlane(s_pre[257]);
  Deal dl = get_deal(p, lds + LDS_BYTES);
  dl.xg = __builtin_amdgcn_readfirstlane(dl.xg); dl.ngroups = __builtin_amdgcn_readfirstlane(dl.ngroups); dl.rk = __builtin_amdgcn_readfirstlane(dl.rk); dl.ng = __builtin_amdgcn_readfirstlane(dl.ng);
  const int ustart = (int)((long long)U * dl.xg / dl.ngroups), uend = (int)((long long)U * (dl.xg + 1) / dl.ngroups);
  const int nrounds = (uend - ustart + dl.ng - 1) / dl.ng;
  bool have = false; int c_e = 0, c_tile = 0, sb = 0;
  u32x4 pre[8];
  u32x4 pre_a;
  auto fetch_a0 = [&](const int* slots, bool sh) {
    const int t3 = opaque_tid();
    const int sl = slots[t3 >> 2];
    const int tok = sl < 0 ? 0 : (sh ? sl : (sl >> 3));
    pre_a = *reinterpret_cast<const u32x4*>((const char*)hin + (size_t)((unsigned)(tok * (DM * 2) + (t3 & 3) * 16)));
  };
  auto fetch_pre1 = [&](int e) {
    const int t3 = opaque_tid(), l3 = t3 & 63, w3 = t3 >> 6;
    const float* wsrc;
    if (e == 256) wsrc = ((w3 & 1) ? p.sw_up : p.sw_gate) + (size_t)layer * DM * EFF;
    else { const size_t eo = (size_t)layer * NEXP + (MOE_HACK == 1 ? 0 : (MOE_HACK == 10 ? (e & ~3) : e)); wsrc = ((w3 & 1) ? p.ew_up : p.ew_gate) + eo * DM * EFF; }
    const char* pb = (const char*)wsrc + (size_t)((unsigned)((((w3 >> 1) * 8) * EFF + l3 * 4) * 4));
#pragma unroll
    for (int i = 0; i < 8; ++i) pre[i] = *reinterpret_cast<const u32x4*>(pb + (size_t)i * (EFF * 4));
  };
  auto find_unit = [&](int u, int& e, int& tile) {
    int lo = 0, hi_ = 256;
    while (lo < hi_) { const int mid = (lo + hi_ + 1) >> 1; if (s_pre[mid] <= u) lo = mid; else hi_ = mid - 1; }
    e = __builtin_amdgcn_readfirstlane(lo); tile = __builtin_amdgcn_readfirstlane(u - s_pre[lo]);
  };
  auto fetch_slots = [&](int e, int tile, int& slot, float& gt) {
    const int t3 = opaque_tid();
    slot = -1; gt = 0.f;
    if (t3 < 128) {
      if (e == 256) { slot = tile * 128 + t3; gt = 1.f; }
      else { const int idx = tile * 128 + t3; if (idx < cnt[e * CNT_STRIDE]) { slot = list[(size_t)e * NTOK + idx]; gt = glist[(size_t)e * NTOK + idx]; } }
    }
  };
  for (int round = 0; round < nrounds; ++round) {
    const int u = ustart + dl.rk + round * dl.ng;
    if (u < uend) {
    int h_slot = -1; float h_gt = 0.f;
    const bool had = have;
    if (!had) { find_unit(u, c_e, c_tile); fetch_slots(c_e, c_tile, h_slot, h_gt); fetch_pre1(c_e); }
    const int e = c_e, tile = c_tile;
    const bool shared = e == 256;
    s_slot = sb ? s_slot1 : s_slot0; s_gate = sb ? s_gate1 : s_gate0;
#if MOE_HACK == 9
    if (!(!shared && tile > 0)) {
#else
    {
#endif
#if MOE_STAGGER
    if (!shared && tile > 0) {
      const unsigned long long t0 = __builtin_amdgcn_s_memrealtime();
      while (__builtin_amdgcn_s_memrealtime() - t0 < (unsigned long long)(MOE_STAGGER * tile)) __builtin_amdgcn_s_sleep(4);
    }
#endif
    __syncthreads();
    tid = opaque_tid(); lane = tid & 63; wid = tid >> 6; r32 = lane & 31; hi = lane >> 5; wm = wid >> 2; wn = wid & 3;
    if (!had && tid < 128) { s_slot[tid] = h_slot; s_gate[tid] = h_gt; }
    __syncthreads();
    if (!had) fetch_a0(s_slot, shared);
    const float *wg, *wu, *wd;
    if (shared) { wg = p.sw_gate + (size_t)layer * DM * EFF; wu = p.sw_up + (size_t)layer * DM * EFF; wd = p.sw_down + (size_t)layer * EFF * DM; }
    else { const size_t eo = (size_t)layer * NEXP + (MOE_HACK == 1 ? 0 : (MOE_HACK == 10 ? (e & ~3) : e)); wg = p.ew_gate + eo * DM * EFF; wu = p.ew_up + eo * DM * EFF; wd = p.ew_down + eo * EFF * DM; }
    f32x16 acc[2][4];
#pragma unroll
    for (int i = 0; i < 2; ++i)
#pragma unroll
      for (int j = 0; j < 4; ++j) acc[i][j] = f32x16{};
    {
      const int sl = s_slot[tid >> 2];
      const int tok = sl < 0 ? 0 : (shared ? sl : (sl >> 3));
      const unsigned aoff = (unsigned)(tok * (DM * 2) + (tid & 3) * 16);
      const int arr = __builtin_amdgcn_readfirstlane(wid) & 1, bk0 = (wid >> 1) * 8, cl = lane * 4;
      const char* bbase = (const char*)(arr ? wu : wg);
      gemm_core<512, 32, true, false, true, float, MOE_PF>(acc, (const char*)hin, aoff, aoff, bbase, (unsigned)((bk0 * EFF + cl) * 4), (unsigned)(EFF * 4), bk0, arr * 256 + cl, (MOE_HACK == 12 ? 8 : DM / 32), lds, nullptr, pre, &pre_a);
    }
    {
      const int t2 = opaque_tid(), l2 = t2 & 63, w2 = t2 >> 6;
      const char* pb = (const char*)wd + (size_t)((unsigned)((((w2 >> 1) * 8) * DM + (w2 & 1) * 256 + l2 * 4) * 4));
#pragma unroll
      for (int i = 0; i < 8; ++i) pre[i] = *reinterpret_cast<const u32x4*>(pb + (size_t)i * (DM * 4));
    }
    tid = opaque_tid(); lane = tid & 63; wid = tid >> 6; r32 = lane & 31; hi = lane >> 5; wm = wid >> 2; wn = wid & 3;
#pragma unroll
    for (int i = 0; i < 2; ++i) {
      const int m = wm * 64 + i * 32 + r32;
#pragma unroll
      for (int j = 0; j < 2; ++j) {
#pragma unroll
        for (int q = 0; q < 4; ++q) {
          float hv[4];
#pragma unroll
          for (int e2 = 0; e2 < 4; ++e2) { const float g = acc[i][j][4 * q + e2], uu = acc[i][j + 2][4 * q + e2]; hv[e2] = g * __builtin_amdgcn_rcpf(1.f + __expf(-g)) * uu; }
          const int chunk = 8 * wn + 4 * j + q;
          u32x2 w = {cvtpk(hv[0], hv[1]), cvtpk(hv[2], hv[3])};
          *reinterpret_cast<u32x2*>(hb + hb_off(m, chunk) + 8 * hi) = w;
        }
      }
    }
    __syncthreads();
    bf16_t* Yo = shared ? Ysh : Y;
#pragma unroll 1
    for (int pz = 0; pz < 2; ++pz) {
#pragma unroll
      for (int i = 0; i < 2; ++i)
#pragma unroll
        for (int j = 0; j < 4; ++j) acc[i][j] = f32x16{};
      {
        const int half = wid & 1, bk0 = (wid >> 1) * 8, cl = half * 256 + lane * 4;
        gemm_core<512, 32, false, true, false, float, MOE_PF>(acc, nullptr, 0u, 0u, (const char*)(wd + pz * 512), (unsigned)((bk0 * DM + cl) * 4), (unsigned)(DM * 4), bk0, cl, EFF / 32, lds, hb, pre);
        if (pz == 0) {
          const char* pb = (const char*)(wd + 512) + (size_t)((unsigned)((bk0 * DM + cl) * 4));
#pragma unroll
          for (int i = 0; i < 8; ++i) pre[i] = *reinterpret_cast<const u32x4*>(pb + (size_t)i * (DM * 4));
        }
      }
      int n_slot = -1; float n_gt = 0.f;
      if (pz == 0) {
        const int un = u + dl.ng;
        have = un < uend;
        if (have) { find_unit(un, c_e, c_tile); fetch_slots(c_e, c_tile, n_slot, n_gt); }
      } else if (have) {
        fetch_a0(sb ? s_slot0 : s_slot1, c_e == 256);
        fetch_pre1(c_e);
      } else {
        pre_a = u32x4{0u, 0u, 0u, 0u};
#pragma unroll
        for (int i = 0; i < 8; ++i) pre[i] = u32x4{0u, 0u, 0u, 0u};
      }
      tid = opaque_tid(); lane = tid & 63; wid = tid >> 6; r32 = lane & 31; hi = lane >> 5; wm = wid >> 2; wn = wid & 3;
      const int odd = lane & 1;
      {
        float* wpatch = reinterpret_cast<float*>(lds + wid * EP_WAVE_BYTES);
#pragma unroll
        for (int i = 0; i < 2; ++i) {
#pragma unroll
          for (int jp = 0; jp < 2; ++jp) {
            epi_to_lds(acc[i][2 * jp], acc[i][2 * jp + 1], wpatch, r32, hi);
#pragma unroll
            for (int it = 0; it < 4; ++it) {
              const int idx = it * 64 + lane, row = idx >> 3, c8 = (idx & 7) * 8;
              const int ml = wm * 64 + i * 32 + row;
              const float g = s_gate[ml]; const int slot = s_slot[ml];
              const f32x4 v0 = *reinterpret_cast<const f32x4*>(wpatch + row * EPW + c8) * g, v1 = *reinterpret_cast<const f32x4*>(wpatch + row * EPW + c8 + 4) * g;
              if (slot >= 0) __builtin_nontemporal_store(cvt8(v0, v1), reinterpret_cast<bf16x8*>(Yo + (size_t)slot * DM + pz * 512 + wn * 128 + jp * 64 + c8));
            }
          }
        }
      }
      if (pz == 0 && have && tid < 128) { int* ns = sb ? s_slot0 : s_slot1; float* ng = sb ? s_gate0 : s_gate1; ns[tid] = n_slot; ng[tid] = n_gt; }
      __syncthreads();
    }
    if (have) sb ^= 1;
    }
    }
    if (dl.census && MOE_ROUND_SYNC) round_barrier(p, lds + LDS_BYTES, layer, round, dl.ng);
  }
}

namespace at {
constexpr int KVBLK = 64;
constexpr int QREG = 8;
constexpr float SCALE = 0.07216878364870323f;
constexpr float THR = 8.f;
constexpr int LDQ = 1536, LDK = 1536, LDV = 1024, LDO = 1024;
constexpr int SHM_V = 16384, SHM_KN = 16384, SHM_KR = 8192;
constexpr int OFF_KN = 2 * SHM_V, OFF_KR = OFF_KN + 2 * SHM_KN, OFF_WS = OFF_KR + 2 * SHM_KR, OFF_QR = OFF_WS + 8 * 64 * 4;
#define KSWZ(row, colB) ((row) * 256 + ((colB) ^ (((row) & 7) << 4)))
#define KRSWZ(row, colB) ((row) * 128 + ((colB) ^ ((((row) >> 1) & 7) << 4)))

__device__ __forceinline__ void partialSM(f32x16& p0, f32x16& p1, float& m_reg, float& mn, float& alpha) {
  constexpr float C = SCALE * 1.4426950408889634f;
  float pmax = p0[0];
#pragma unroll
  for (int r = 1; r < 16; ++r) pmax = fmaxf(pmax, p0[r]);
#pragma unroll
  for (int r = 0; r < 16; ++r) pmax = fmaxf(pmax, p1[r]);
  { auto rr = __builtin_amdgcn_permlane32_swap(__float_as_uint(pmax), __float_as_uint(pmax), false, false);
    pmax = fmaxf(__uint_as_float(rr[0]), __uint_as_float(rr[1])); }
  if (__builtin_expect(__all(pmax - m_reg <= THR / SCALE), 1)) { mn = m_reg; alpha = 1.f; }
  else { mn = fmaxf(m_reg, pmax); alpha = __builtin_amdgcn_exp2f((m_reg - mn) * C); m_reg = mn; }
  const float mnC = -mn * C;
#pragma unroll
  for (int r = 0; r < 16; ++r) p0[r] = fmaf(p0[r], C, mnC);
#pragma unroll
  for (int r = 0; r < 16; ++r) p1[r] = fmaf(p1[r], C, mnC);
#pragma unroll
  for (int r = 0; r < 16; ++r) p0[r] = __builtin_amdgcn_exp2f(p0[r]);
}
__device__ __forceinline__ void finishSM(f32x16& p0, f32x16& p1, float alpha, float& l_reg, bf16x8& pa0, bf16x8& pa1, bf16x8& pa2, bf16x8& pa3) {
#pragma unroll
  for (int r = 0; r < 16; ++r) p1[r] = __builtin_amdgcn_exp2f(p1[r]);
  float ps = 0;
#pragma unroll
  for (int r = 0; r < 16; ++r) ps += p0[r];
#pragma unroll
  for (int r = 0; r < 16; ++r) ps += p1[r];
  { auto rr = __builtin_amdgcn_permlane32_swap(__float_as_uint(ps), __float_as_uint(ps), false, false);
    ps = __uint_as_float(rr[0]) + __uint_as_float(rr[1]); }
  l_reg = l_reg * alpha + ps;
#define PK4(P, BASE, OUT) do { unsigned a0 = cvtpk(P[BASE + 0], P[BASE + 1]), a1 = cvtpk(P[BASE + 2], P[BASE + 3]);   \
    unsigned b0 = cvtpk(P[BASE + 4], P[BASE + 5]), b1 = cvtpk(P[BASE + 6], P[BASE + 7]);                              \
    auto r0 = __builtin_amdgcn_permlane32_swap(a0, b0, false, false); auto r1 = __builtin_amdgcn_permlane32_swap(a1, b1, false, false); \
    u32x4 w = {r0[0], r1[0], r0[1], r1[1]}; OUT = *reinterpret_cast<bf16x8*>(&w); } while (0)
  PK4(p0, 0, pa0); PK4(p0, 8, pa1); PK4(p1, 0, pa2); PK4(p1, 8, pa3);
#undef PK4
}
__device__ __forceinline__ void qkt(f32x16& p0, f32x16& p1, const char* Kn, const char* Kr, const bf16x8* qr, const char* qrl, int r32, int hi) {
  p0 = f32x16{}; p1 = f32x16{};
#pragma unroll
  for (int d0 = 0; d0 < QREG; ++d0) { const int cb = (d0 * 16 + hi * 8) * 2;
    const bf16x8 b0 = *reinterpret_cast<const bf16x8*>(Kn + KSWZ(r32, cb));
    const bf16x8 b1 = *reinterpret_cast<const bf16x8*>(Kn + KSWZ(32 + r32, cb));
    p0 = __builtin_amdgcn_mfma_f32_32x32x16_bf16(b0, qr[d0], p0, 0, 0, 0);
    p1 = __builtin_amdgcn_mfma_f32_32x32x16_bf16(b1, qr[d0], p1, 0, 0, 0); }
#pragma unroll
  for (int d0 = QREG; d0 < 8; ++d0) { const int cb = (d0 * 16 + hi * 8) * 2;
    const bf16x8 b0 = *reinterpret_cast<const bf16x8*>(Kn + KSWZ(r32, cb));
    const bf16x8 b1 = *reinterpret_cast<const bf16x8*>(Kn + KSWZ(32 + r32, cb));
    const bf16x8 qv = *reinterpret_cast<const bf16x8*>(qrl + (d0 - QREG) * 8192);
    p0 = __builtin_amdgcn_mfma_f32_32x32x16_bf16(b0, qv, p0, 0, 0, 0);
    p1 = __builtin_amdgcn_mfma_f32_32x32x16_bf16(b1, qv, p1, 0, 0, 0); }
#pragma unroll
  for (int d0 = 0; d0 < 4; ++d0) { const int cb = (d0 * 16 + hi * 8) * 2;
    const bf16x8 b0 = *reinterpret_cast<const bf16x8*>(Kr + KRSWZ(r32, cb));
    const bf16x8 b1 = *reinterpret_cast<const bf16x8*>(Kr + KRSWZ(32 + r32, cb));
    const bf16x8 qv = *reinterpret_cast<const bf16x8*>(qrl + (8 - QREG + d0) * 8192);
    p0 = __builtin_amdgcn_mfma_f32_32x32x16_bf16(b0, qv, p0, 0, 0, 0);
    p1 = __builtin_amdgcn_mfma_f32_32x32x16_bf16(b1, qv, p1, 0, 0, 0); }
}
__device__ __forceinline__ int v_st(int k, int c) { const int kk = (k & ~0xC) | ((k & 4) << 1) | ((k & 8) >> 1); return ((kk >> 3) * 4 + (c >> 5)) * 512 + ((kk & 7) * 32 + (c & 31)) * 2; }
constexpr int v_rd_off(int d0, int ks, int half) { return d0 * 512 + ks * 4096 + half * 2048; }
template <int D0> __device__ __forceinline__ void pv_one(f32x16& od, int vb, bf16x8 pa0, bf16x8 pa1, bf16x8 pa2, bf16x8 pa3) {
  const s16x4 l0 = tr_read<v_rd_off(D0, 0, 0)>(vb), h0 = tr_read<v_rd_off(D0, 0, 1)>(vb), l1 = tr_read<v_rd_off(D0, 1, 0)>(vb), h1 = tr_read<v_rd_off(D0, 1, 1)>(vb);
  const s16x4 l2 = tr_read<v_rd_off(D0, 2, 0)>(vb), h2 = tr_read<v_rd_off(D0, 2, 1)>(vb), l3 = tr_read<v_rd_off(D0, 3, 0)>(vb), h3 = tr_read<v_rd_off(D0, 3, 1)>(vb);
  asm volatile("s_waitcnt lgkmcnt(0)" ::: "memory"); SBAR();
  od = __builtin_amdgcn_mfma_f32_32x32x16_bf16(pa0, PKF(l0, h0), od, 0, 0, 0);
  od = __builtin_amdgcn_mfma_f32_32x32x16_bf16(pa1, PKF(l1, h1), od, 0, 0, 0);
  od = __builtin_amdgcn_mfma_f32_32x32x16_bf16(pa2, PKF(l2, h2), od, 0, 0, 0);
  od = __builtin_amdgcn_mfma_f32_32x32x16_bf16(pa3, PKF(l3, h3), od, 0, 0, 0);
}
__device__ __forceinline__ void pv_d0(f32x16* o, int vb, bf16x8 pa0, bf16x8 pa1, bf16x8 pa2, bf16x8 pa3) {
  pv_one<0>(o[0], vb, pa0, pa1, pa2, pa3); pv_one<1>(o[1], vb, pa0, pa1, pa2, pa3); pv_one<2>(o[2], vb, pa0, pa1, pa2, pa3); pv_one<3>(o[3], vb, pa0, pa1, pa2, pa3);
}

__device__ __forceinline__ void attn_body(const bf16_t* __restrict__ Qb, const bf16_t* __restrict__ Kh, const bf16_t* __restrict__ Vh,
                                          bf16_t* __restrict__ Ob, int seq, char* lds) {
  const int tid = opaque_tid(), wid = tid >> 6, lane = tid & 63, r32 = lane & 31, hi = lane >> 5;
  char* V_lds = lds; char* KN_lds = lds + OFF_KN; char* KR_lds = lds + OFF_KR;
  float* ws = (float*)(lds + OFF_WS) + wid * 64; float* li_l = ws; float* al_l = ws + 32;
  float m_reg = -1e30f, l_reg = 0; f32x16 o[4] = {}; bf16x8 qr[QREG];
  char* qrl = lds + OFF_QR + tid * 16;
  {
    const char* Qc = (const char*)Qb; const unsigned qoff = (unsigned)(((wid * 32 + r32) * LDQ + hi * 8) * 2);
#pragma unroll
    for (int d0 = 0; d0 < QREG; ++d0) qr[d0] = *reinterpret_cast<const bf16x8*>(Qc + qoff + d0 * 32);
#pragma unroll
    for (int d0 = QREG; d0 < 12; ++d0) *reinterpret_cast<bf16x8*>(qrl + (d0 - QREG) * 8192) = *reinterpret_cast<const bf16x8*>(Qc + qoff + d0 * 32);
  }
  const int sr = tid >> 4, sc = (tid & 15) * 8, vst0 = v_st(sr, sc), vst1 = v_st(32 + sr, sc);
  const int krr = tid >> 3, krc = (tid & 7) * 8;
  const int vb0 = (int)(uintptr_t)V_lds + v_rd_base(lane);
  const unsigned voff0 = (unsigned)((sr * LDV + sc) * 2), voff1 = voff0 + 32 * LDV * 2;
  const unsigned koff0 = (unsigned)((sr * LDK + sc) * 2), koff1 = koff0 + 32 * LDK * 2, koffr = (unsigned)((krr * LDK + DNOPE + krc) * 2);
  const char* Vc = (const char*)Vh; const char* Kc = (const char*)Kh;
  bf16x8 s_vs0, s_vs1, s_ks0, s_ks1, s_kr;
#define SLOAD(k0) do { const char* vt = Vc + (size_t)(k0) * (LDV * 2); const char* kt_ = Kc + (size_t)(k0) * (LDK * 2);                    \
    s_vs0 = *reinterpret_cast<const bf16x8*>(vt + voff0); s_vs1 = *reinterpret_cast<const bf16x8*>(vt + voff1);                          \
    s_ks0 = *reinterpret_cast<const bf16x8*>(kt_ + koff0); s_ks1 = *reinterpret_cast<const bf16x8*>(kt_ + koff1);                        \
    s_kr = *reinterpret_cast<const bf16x8*>(kt_ + koffr); } while (0)
#define SWRITE(b) do { *(bf16x8*)(V_lds + (b) * SHM_V + vst0) = s_vs0; *(bf16x8*)(V_lds + (b) * SHM_V + vst1) = s_vs1; const int kc = sc * 2; \
    *(bf16x8*)(KN_lds + (b) * SHM_KN + KSWZ(sr, kc)) = s_ks0; *(bf16x8*)(KN_lds + (b) * SHM_KN + KSWZ(32 + sr, kc)) = s_ks1;   \
    *(bf16x8*)(KR_lds + (b) * SHM_KR + KRSWZ(krr, krc * 2)) = s_kr; } while (0)
#define SWAIT() asm volatile("s_waitcnt vmcnt(0)" ::: "memory")
#define RESC(a) do { if (__any((a) < 1.f)) { if (hi == 0) al_l[r32] = (a); asm volatile("s_waitcnt lgkmcnt(0)" ::: "memory"); \
    for (int d = 0; d < 4; ++d) for (int r = 0; r < 16; ++r) o[d][r] *= al_l[crow(r, hi)]; } } while (0)
  f32x16 pA0, pA1, pB0, pB1; float mnA, mnB, alA, alB; bf16x8 pa0, pa1, pa2, pa3; const int NT = seq / KVBLK;
  if (__builtin_amdgcn_readfirstlane(tid) >= 256) __builtin_amdgcn_s_setprio(1);
  SLOAD(0); SWAIT(); SWRITE(0); __syncthreads();
  qkt(pA0, pA1, KN_lds, KR_lds, qr, qrl, r32, hi); partialSM(pA0, pA1, m_reg, mnA, alA);
  SLOAD(KVBLK);
  SWAIT(); SWRITE(1); __syncthreads();
#pragma unroll 1
  for (int j = 1; j + 1 < NT; j += 2) {
    SBAR(); qkt(pB0, pB1, KN_lds + SHM_KN, KR_lds + SHM_KR, qr, qrl, r32, hi);
    finishSM(pA0, pA1, alA, l_reg, pa0, pa1, pa2, pa3); SBAR();
    SLOAD((j + 1) * KVBLK); SBAR();
    pv_d0(o, vb0, pa0, pa1, pa2, pa3); partialSM(pB0, pB1, m_reg, mnB, alB);
    __syncthreads(); SWAIT(); SWRITE(0);
    RESC(alB); __syncthreads();
    SBAR(); qkt(pA0, pA1, KN_lds, KR_lds, qr, qrl, r32, hi);
    finishSM(pB0, pB1, alB, l_reg, pa0, pa1, pa2, pa3); SBAR();
    SLOAD((j + 2) * KVBLK); SBAR();
    pv_d0(o, vb0 + SHM_V, pa0, pa1, pa2, pa3); partialSM(pA0, pA1, m_reg, mnA, alA);
    __syncthreads(); SWAIT(); SWRITE(1);
    RESC(alA); __syncthreads();
  }
  SBAR(); qkt(pB0, pB1, KN_lds + SHM_KN, KR_lds + SHM_KR, qr, qrl, r32, hi);
  finishSM(pA0, pA1, alA, l_reg, pa0, pa1, pa2, pa3); SBAR();
  pv_d0(o, vb0, pa0, pa1, pa2, pa3); partialSM(pB0, pB1, m_reg, mnB, alB);
  __syncthreads(); RESC(alB);
  finishSM(pB0, pB1, alB, l_reg, pa0, pa1, pa2, pa3); SBAR();
  pv_d0(o, vb0 + SHM_V, pa0, pa1, pa2, pa3);
  if (hi == 0) li_l[r32] = l_reg; asm volatile("s_waitcnt lgkmcnt(0)" ::: "memory");
  float rli[16];
#pragma unroll
  for (int r = 0; r < 16; ++r) rli[r] = __builtin_amdgcn_rcpf(li_l[crow(r, hi)]);
  char* Oc = (char*)Ob;
  const int tid2 = opaque_tid(), lane2 = tid2 & 63, odd = lane2 & 1, hi2 = lane2 >> 5;
#pragma unroll
  for (int r = 0; r < 16; r += 2) {
    const unsigned ooff = (unsigned)((((tid2 >> 6) * 32 + crow(r, hi2) + odd) * LDO + (lane2 & 30)) * 2);
#pragma unroll
    for (int d0 = 0; d0 < 4; ++d0) {
      const unsigned pk = pack_pair(o[d0][r] * rli[r], o[d0][r + 1] * rli[r + 1], odd);
      *reinterpret_cast<unsigned*>(Oc + ooff + d0 * 64) = pk;
    }
  }
  __builtin_amdgcn_s_setprio(0);
#undef SLOAD
#undef SWRITE
#undef SWAIT
#undef RESC
}
}

__device__ __forceinline__ void phase_attn(const Params& p, char* lds) {
  const bf16_t* Q = (const bf16_t*)(p.ws + OFF_Q); const bf16_t* Kb = (const bf16_t*)(p.ws + OFF_K); const bf16_t* V = (const bf16_t*)(p.ws + OFF_V);
  bf16_t* O = (bf16_t*)(p.ws + OFF_O);
  const Deal dl = get_deal(p, lds + LDS_BYTES);
  for (int pair = dl.xg; pair < 16; pair += dl.ngroups) {
    const int b = pair >> 3, h = pair & 7;
    const size_t t0 = (size_t)b * SEQ;
    for (int qb = dl.rk; qb < 32; qb += dl.ng) {
      __syncthreads();
      at::attn_body(Q + (t0 + qb * 256) * 1536 + h * DQK, Kb + t0 * 1536 + h * DQK, V + t0 * 1024 + h * DVH, O + (t0 + qb * 256) * 1024 + h * DVH, SEQ, lds);
    }
  }
}


#if PROBE_T
#ifndef BENCH_MODE
#define BENCH_MODE 2
#endif
__device__ __forceinline__ void phase_bench(const Params& p) {
  const int tid = threadIdx.x, lane = tid & 63, wid = tid >> 6;
  const char* base = (const char*)(p.ew_gate + (size_t)(blockIdx.x % NEXP) * DM * EFF) + (size_t)((wid * 8) * EFF + lane * 4) * 4;
  u32x4 acc = {0, 0, 0, 0};
#if BENCH_MODE == 1
#pragma unroll 1
  for (int kt = 0; kt < 48; ++kt) {
    u32x4 v[8];
#pragma unroll
    for (int i = 0; i < 8; ++i) v[i] = *reinterpret_cast<const u32x4*>(base + (size_t)kt * 65536 + i * 1024);
#pragma unroll
    for (int i = 0; i < 8; ++i) acc ^= v[i];
    __syncthreads();
  }
#else
  u32x4 v0[8], v1[8];
#pragma unroll
  for (int i = 0; i < 8; ++i) v0[i] = *reinterpret_cast<const u32x4*>(base + i * 1024);
#pragma unroll 1
  for (int kt = 0; kt < 48; kt += 2) {
#pragma unroll
    for (int i = 0; i < 8; ++i) v1[i] = *reinterpret_cast<const u32x4*>(base + (size_t)(kt + 1) * 65536 + i * 1024);
#pragma unroll
    for (int i = 0; i < 8; ++i) acc ^= v0[i];
    __syncthreads();
#pragma unroll
    for (int i = 0; i < 8; ++i) v0[i] = *reinterpret_cast<const u32x4*>(base + (size_t)((kt + 2) % 48) * 65536 + i * 1024);
#pragma unroll
    for (int i = 0; i < 8; ++i) acc ^= v1[i];
    __syncthreads();
  }
#pragma unroll
  for (int i = 0; i < 8; ++i) acc ^= v0[i];
#endif
  if (acc[0] == 0x12345678u && acc[1] == 0x9abcdefu) ((unsigned*)(p.ws + OFF_DBG))[tid & 31] = acc[2];
}
#endif

constexpr int NPHASE = 17;
template <int PH> __device__ __forceinline__ void run_phase(const Params& p, char* lds) {
  char* ws = p.ws;
  if constexpr (PH == 0) phase_prologue(p, lds);
  else if constexpr (PH == 1) phase_pool_gemm(p, lds);
  else if constexpr (PH == 2) phase_ln(p, p.ln_mix_g, p.ln_mix_b, nullptr, (bf16_t*)(ws + OFF_H0B));
  else if constexpr (PH == 3) phase_router_gemm(p, lds, 0);
  else if constexpr (PH == 4) phase_route(p, lds, 0);
#if PROBE_T && defined(BENCH_ON)
  else if constexpr (PH == 5) phase_bench(p);
#else
  else if constexpr (PH == 5) phase_moe(p, lds, 0);
#endif
  else if constexpr (PH == 6) phase_combine_ln(p, (const bf16_t*)(ws + OFF_H0B), p.ln_ffn_g, p.ln_ffn_b, nullptr, (bf16_t*)(ws + OFF_H1B));
  else if constexpr (PH == 7) phase_wa_gemm(p, lds);
  else if constexpr (PH == 8) phase_mla_rows(p);
  else if constexpr (PH == 9) phase_qkv_gemm(p, lds);
  else if constexpr (PH == 10) phase_attn(p, lds);
  else if constexpr (PH == 11) phase_wo_gemm(p, lds);
  else if constexpr (PH == 12) phase_ln(p, p.ln_mix_g + DM, p.ln_mix_b + DM, nullptr, (bf16_t*)(ws + OFF_H0B));
  else if constexpr (PH == 13) phase_router_gemm(p, lds, 1);
  else if constexpr (PH == 14) phase_route(p, lds, 1);
  else if constexpr (PH == 15) phase_moe(p, lds, 1);
  else if constexpr (PH == 16) phase_combine_ln(p, (const bf16_t*)(ws + OFF_H0B), p.ln_ffn_g + DM, p.ln_ffn_b + DM, p.out, nullptr);
}

template <int PH> __global__ void __launch_bounds__(NTHR, 2) k_phase(Params p) {
  extern __shared__ __attribute__((aligned(16))) char lds[];
  if (threadIdx.x == 0) *reinterpret_cast<uint4*>(lds + LDS_BYTES) = make_uint4(0u, 0u, ~0u, 0u);
  __syncthreads();
  run_phase<PH>(p, lds);
}

constexpr size_t OFF_TS = 20480;
template <int PH> __device__ __forceinline__ void run_all(const Params& p, char* lds, const XcdBarrier& bar) {
#if PROBE_T
  if (blockIdx.x == 0 && threadIdx.x == 0) ((unsigned long long*)(p.ws + OFF_TS))[PH] = __builtin_amdgcn_s_memrealtime();
#endif
  run_phase<PH>(p, lds);
  if constexpr (PH + 1 < NPHASE) { xcd_barrier(bar); run_all<PH + 1>(p, lds, bar); }
}
__global__ void __launch_bounds__(NTHR, 2) k_mega(Params p) {
  extern __shared__ __attribute__((aligned(16))) char lds[];
  uint4* xbw = reinterpret_cast<uint4*>(lds + LDS_BYTES);
  if (threadIdx.x == 0) {
    const unsigned x = xb_xcc_id();
    const unsigned r = xb_add((unsigned*)(p.ws + OFF_XCENSUS) + x, 1u);
    *xbw = make_uint4(0u, 0u, x, r);
  }
  __syncthreads();
  XcdBarrier bar = xcd_barrier_post((unsigned*)(p.ws + OFF_BAR), (volatile LAS unsigned*)xbw);
  run_all<0>(p, lds, bar);
#if PROBE_T
  xcd_barrier(bar);
  if (blockIdx.x == 0 && threadIdx.x == 0) ((unsigned long long*)(p.ws + OFF_TS))[NPHASE] = __builtin_amdgcn_s_memrealtime();
  xcd_barrier(bar);
  {
    const unsigned long long* ts = (const unsigned long long*)(p.ws + OFF_TS);
    const float v1 = (float)(ts[PROBE_A1] - ts[PROBE_A0]) * 0.01f * PROBE_SCALE;
    for (size_t i = (size_t)blockIdx.x * NTHR + threadIdx.x; i < (size_t)NTOK * DM; i += (size_t)gridDim.x * NTHR) p.out[i] = (i == 0) ? v1 : 1.f;
  }
#endif
}

#if DBG
__device__ __forceinline__ void dbg_max(float* slot, float v) { atomicMax((unsigned*)slot, __float_as_uint(v)); }
__global__ void chk_gemm(const bf16_t* A, int lda, const float* W, int ldw, int K, int N, const float* Cf, const bf16_t* Cb, int ldc, int mode, const Params p, float* slot, float scale) {
  const int s = blockIdx.x * blockDim.x + threadIdx.x;
  const int t = (int)(((unsigned)s * 2654435761u) % NTOK), n = (int)(((unsigned)s * 40503u + 17u) % (unsigned)N);
  float ref = 0.f;
  for (int k = 0; k < K; ++k) ref += bf2f(A[(size_t)t * lda + k]) * W[(size_t)k * ldw + n];
  float got;
  if (mode == 0) got = Cf[(size_t)t * ldc + n];
  else if (mode == 1) { got = Cf[(size_t)t * ldc + n]; ref = (ref + p.pool_b[n]) * p.pool_scale[n] + ALPHA * p.x[(size_t)t * DM + n]; }
  else if (mode == 2) { got = Cf[(size_t)t * ldc + n] - ALPHA * ((const float*)(p.ws + OFF_H1F))[(size_t)t * DM + n]; }
  else if (mode == 3) got = bf2f(Cb[(size_t)t * ldc + n]);
  else if (mode == 4) got = bf2f(Cb[(size_t)t * ldc + (n >> 7) * 192 + (n & 127)]);
  else {
    const int h = n / 192, d = n % 192;
    got = bf2f(Cb[(size_t)t * ldc + n]);
    if (d >= 128) {
      const int j = (d - 128) & 31; const bool second = d >= 160;
      const int n1 = h * 192 + 128 + j, n2 = n1 + 32;
      float x1 = 0.f, x2 = 0.f;
      for (int k = 0; k < K; ++k) { const float a = bf2f(A[(size_t)t * lda + k]); x1 += a * W[(size_t)k * ldw + n1]; x2 += a * W[(size_t)k * ldw + n2]; }
      const int pos = t & (SEQ - 1);
      const double inv = pow(10000.0, -(double)(2 * j) / 64.0), ang = pos * inv;
      const float c = (float)cos(ang), sn = (float)sin(ang);
      ref = second ? x1 * sn + x2 * c : x1 * c - x2 * sn;
    }
  }
  dbg_max(slot, fabsf(got - ref) / (fabsf(ref) + scale));
}
__global__ void chk_pool(const Params p, float* slot) {
  const int s = blockIdx.x * blockDim.x + threadIdx.x;
  const int t = (int)(((unsigned)s * 2654435761u) % NTOK), n = (int)(((unsigned)s * 40503u + 17u) % DM);
  const int g = n >> 8, half = 1 << g, pos = t & (SEQ - 1), tb = t - pos;
  const float* x = p.x; const bf16_t* pooled = (const bf16_t*)(p.ws + OFF_POOLED);
  float ref = 0.f;
  for (int k = 0; k < 256; ++k) {
    const int c = g * 256 + k; float sum = 0.f; int cn = 0;
    for (int r = pos - half; r < pos + half; ++r) if (r >= 0 && r < SEQ) { sum += x[(size_t)(tb + r) * DM + c]; ++cn; }
    const float pl = sum / cn - x[(size_t)t * DM + c];
    if (k == (n & 255)) dbg_max(slot, fabsf(bf2f(pooled[(size_t)t * DM + c]) - pl) / (fabsf(pl) + 0.5f));
    ref += pl * p.pool_w[((size_t)g * 256 + k) * 256 + (n & 255)];
  }
  ref = (ref + p.pool_b[n]) * p.pool_scale[n] + ALPHA * x[(size_t)t * DM + n];
  dbg_max(slot + 1, fabsf(((const float*)(p.ws + OFF_Z))[(size_t)t * DM + n] - ref) / (fabsf(ref) + 0.5f));
}
__global__ void chk_route(const Params p, int layer, float* slot) {
  const int s = blockIdx.x * blockDim.x + threadIdx.x;
  const int t = (int)(((unsigned)s * 2654435761u) % NTOK);
  const float* lg = (const float*)(p.ws + OFF_LOGIT) + (size_t)t * NEXP;
  const float* rb = p.router_b + layer * NEXP;
  float gs[8];
  for (int g = 0; g < 8; ++g) { float m1 = -1e30f, m2 = -1e30f; for (int k = 0; k < 32; ++k) { const float v = 1.f / (1.f + expf(-lg[g * 32 + k])) + rb[g * 32 + k]; if (v > m1) { m2 = m1; m1 = v; } else if (v > m2) m2 = v; } gs[g] = m1 + m2; }
  bool sel[8];
  for (int g = 0; g < 8; ++g) { int rank = 0; for (int g2 = 0; g2 < 8; ++g2) rank += (gs[g2] > gs[g] || (gs[g2] == gs[g] && g2 < g)); sel[g] = rank < 4; }
  int ei[8]; float es[8]; float ssum = 0.f; unsigned long long used[4] = {0, 0, 0, 0};
  for (int kk = 0; kk < 8; ++kk) { float best = -1e30f; int bi = -1;
    for (int e = 0; e < 256; ++e) { if (!sel[e >> 5] || ((used[e >> 6] >> (e & 63)) & 1)) continue; const float v = 1.f / (1.f + expf(-lg[e])) + rb[e]; if (v > best) { best = v; bi = e; } }
    used[bi >> 6] |= 1ull << (bi & 63); ei[kk] = bi; es[kk] = 1.f / (1.f + expf(-lg[bi])); ssum += es[kk]; }
  const int* texp = (const int*)(p.ws + OFF_TEXP); const float* gate = (const float*)(p.ws + OFF_GATE);
  float err = 0.f;
  for (int kk = 0; kk < 8; ++kk) { if (texp[t * 8 + kk] != ei[kk]) err = 10.f; err = fmaxf(err, fabsf(gate[t * 8 + kk] - es[kk] / ssum * 2.5f)); }
  const int* cnt = (const int*)(p.ws + OFF_CNTP) + layer * NEXP * CNT_STRIDE; const int* list = (const int*)(p.ws + OFF_LIST);
  const int e = s & 255; const int c = cnt[e * CNT_STRIDE];
  if (c > 0) { const int idx = (int)(((unsigned)s * 7919u) % (unsigned)c); const int ent = list[(size_t)e * NTOK + idx]; if (ent < 0 || ent >= NTOK * 8 || texp[ent] != e) err = 20.f; }
  if (s == 0) { int tot = 0; for (int i = 0; i < 256; ++i) tot += cnt[i * CNT_STRIDE]; if (tot != NTOK * 8) err = 30.f; }
  dbg_max(slot, err);
}
__global__ void chk_moe(const Params p, int layer, float* slot) {
  __shared__ float hbs[256];
  const int s = blockIdx.x; const int t = (int)(((unsigned)s * 2654435761u + 12345u) % NTOK), k = s % 9;
  const bf16_t* h = (const bf16_t*)(p.ws + OFF_H0B) + (size_t)t * DM;
  const int* texp = (const int*)(p.ws + OFF_TEXP); const float* gate = (const float*)(p.ws + OFF_GATE);
  const float *wg, *wu, *wd; float g = 1.f; const bf16_t* y;
  if (k == 8) { wg = p.sw_gate + (size_t)layer * DM * EFF; wu = p.sw_up + (size_t)layer * DM * EFF; wd = p.sw_down + (size_t)layer * EFF * DM; y = (const bf16_t*)(p.ws + OFF_YSH) + (size_t)t * DM; }
  else { const int e = texp[t * 8 + k]; const size_t eo = (size_t)layer * NEXP + e; wg = p.ew_gate + eo * DM * EFF; wu = p.ew_up + eo * DM * EFF; wd = p.ew_down + eo * EFF * DM; g = gate[t * 8 + k]; y = (const bf16_t*)(p.ws + OFF_Y) + ((size_t)t * 8 + k) * DM; }
  const int f = threadIdx.x; float a = 0.f, b = 0.f;
  for (int d = 0; d < DM; ++d) { const float hv = bf2f(h[d]); a += hv * wg[(size_t)d * EFF + f]; b += hv * wu[(size_t)d * EFF + f]; }
  hbs[f] = a / (1.f + expf(-a)) * b;
  __syncthreads();
  for (int n = f; n < DM; n += 256) { float r = 0.f; for (int ff = 0; ff < EFF; ++ff) r += hbs[ff] * wd[(size_t)ff * DM + n]; r *= g;
    dbg_max(slot, fabsf(bf2f(y[n]) - r) / (fabsf(r) + 0.05f)); }
}
__global__ void chk_ln(const Params p, const float* zin, int combine, const float* hres, const float* g, const float* b, const float* of, float* slot) {
  const int s = blockIdx.x * blockDim.x + threadIdx.x; const int t = (int)(((unsigned)s * 2654435761u + 99u) % NTOK);
  const bf16_t* Y = (const bf16_t*)(p.ws + OFF_Y); const bf16_t* Ysh = (const bf16_t*)(p.ws + OFF_YSH);
  double mu = 0, var = 0;
  auto val = [&](int c) -> float { if (!combine) return zin[(size_t)t * DM + c]; float v = ALPHA * hres[(size_t)t * DM + c] + bf2f(Ysh[(size_t)t * DM + c]); for (int k = 0; k < 8; ++k) v += bf2f(Y[((size_t)t * 8 + k) * DM + c]); return v; };
  for (int c = 0; c < DM; ++c) mu += val(c);
  mu /= DM;
  for (int c = 0; c < DM; ++c) { const double d = val(c) - mu; var += d * d; }
  var /= DM; const float rstd = (float)(1.0 / sqrt(var + 1e-5));
  float err = 0.f;
  for (int c = 0; c < DM; c += 7) { const float ref = (float)(val(c) - mu) * rstd * g[c] + b[c]; err = fmaxf(err, fabsf(of[(size_t)t * DM + c] - ref) / (fabsf(ref) + 0.5f)); }
  dbg_max(slot, err);
}
__global__ void chk_mla_rows(const Params p, float* slot) {
  const int s = blockIdx.x * blockDim.x + threadIdx.x; const int t = (int)(((unsigned)s * 2654435761u + 7u) % NTOK);
  const float* a = (const float*)(p.ws + OFF_ABUF) + (size_t)t * WA_NP;
  const bf16_t* ql = (const bf16_t*)(p.ws + OFF_QLAT) + (size_t)t * QL; const bf16_t* kvl = (const bf16_t*)(p.ws + OFF_KVLAT) + (size_t)t * KVL; const bf16_t* Kb = (const bf16_t*)(p.ws + OFF_K) + (size_t)t * 1536;
  double sq = 0, sk = 0; for (int i = 0; i < QL; ++i) sq += (double)a[i] * a[i]; for (int i = 0; i < KVL; ++i) sk += (double)a[QL + i] * a[QL + i];
  const float rq = (float)(1.0 / sqrt(sq / QL + 1e-6)), rk = (float)(1.0 / sqrt(sk / KVL + 1e-6));
  float err = 0.f;
  for (int i = 0; i < QL; ++i) { const float r = a[i] * rq * p.qn_g[i]; err = fmaxf(err, fabsf(bf2f(ql[i]) - r) / (fabsf(r) + 0.5f)); }
  for (int i = 0; i < KVL; ++i) { const float r = a[QL + i] * rk * p.kvn_g[i]; err = fmaxf(err, fabsf(bf2f(kvl[i]) - r) / (fabsf(r) + 0.5f)); }
  const int pos = t & (SEQ - 1);
  for (int j = 0; j < 32; ++j) { const double inv = pow(10000.0, -(double)(2 * j) / 64.0), ang = pos * inv; const float c = (float)cos(ang), sn = (float)sin(ang);
    const float x1 = a[640 + j], x2 = a[672 + j]; const float r1 = x1 * c - x2 * sn, r2 = x1 * sn + x2 * c;
    for (int h = 0; h < NH; h += 3) { err = fmaxf(err, fabsf(bf2f(Kb[h * 192 + 128 + j]) - r1) / (fabsf(r1) + 0.5f)); err = fmaxf(err, fabsf(bf2f(Kb[h * 192 + 160 + j]) - r2) / (fabsf(r2) + 0.5f)); } }
  dbg_max(slot, err);
}
__global__ void chk_attn(const Params p, float* slot) {
  __shared__ float red[256]; __shared__ float qs[192]; __shared__ float osum[128];
  const int s = blockIdx.x; const int t = (int)(((unsigned)s * 2654435761u + 5u) % NTOK), h = s & 7;
  const int b = t >> 13; const size_t t0 = (size_t)b * SEQ;
  const bf16_t* Q = (const bf16_t*)(p.ws + OFF_Q) + (size_t)t * 1536 + h * 192;
  const bf16_t* Kb = (const bf16_t*)(p.ws + OFF_K) + t0 * 1536 + h * 192; const bf16_t* V = (const bf16_t*)(p.ws + OFF_V) + t0 * 1024 + h * 128;
  const bf16_t* O = (const bf16_t*)(p.ws + OFF_O) + (size_t)t * 1024 + h * 128;
  const int tid = threadIdx.x;
  if (tid < 192) qs[tid] = bf2f(Q[tid]); if (tid < 128) osum[tid] = 0.f;
  __syncthreads();
  float sc[32]; float mx = -1e30f;
  for (int i = 0; i < 32; ++i) { const int key = tid + 256 * i; float d = 0.f; for (int c = 0; c < 192; ++c) d += qs[c] * bf2f(Kb[(size_t)key * 1536 + c]); sc[i] = d * 0.07216878364870323f; mx = fmaxf(mx, sc[i]); }
  red[tid] = mx; __syncthreads();
  for (int o = 128; o > 0; o >>= 1) { if (tid < o) red[tid] = fmaxf(red[tid], red[tid + o]); __syncthreads(); }
  mx = red[0]; __syncthreads();
  float sum = 0.f; for (int i = 0; i < 32; ++i) { sc[i] = expf(sc[i] - mx); sum += sc[i]; }
  red[tid] = sum; __syncthreads();
  for (int o = 128; o > 0; o >>= 1) { if (tid < o) red[tid] += red[tid + o]; __syncthreads(); }
  sum = red[0]; __syncthreads();
  for (int d = 0; d < 128; ++d) { float a = 0.f; for (int i = 0; i < 32; ++i) a += sc[i] * bf2f(V[(size_t)(tid + 256 * i) * 1024 + d]); atomicAdd(&osum[d], a); }
  __syncthreads();
  if (tid < 128) { const float r = osum[tid] / sum; dbg_max(slot, fabsf(bf2f(O[tid]) - r) / (fabsf(r) + 0.01f)); }
}
__global__ void dbg_report(const float* err, int nstage, float tol, float* out, int n) {
  int first = -1;
  for (int i = 0; i < nstage; ++i) if (i != 2 && !(err[i] <= tol)) { first = i; break; }
  if (first < 0) return;
  float e = err[first]; float m = 1.f + 2.f * log10f(fmaxf(e / tol, 1.f)); if (!(m < 9.5f)) m = 9.5f;
  const float v = m * powf(10.f, 3.f + first);
  for (int i = blockIdx.x * blockDim.x + threadIdx.x; i < n; i += gridDim.x * blockDim.x) out[i] = v;
}
#endif

template <int PH> static void launch_phase(const Params& p, int grid, hipStream_t stream) {
  static bool attr = false;
  if (!attr) { hipFuncSetAttribute((const void*)k_phase<PH>, hipFuncAttributeMaxDynamicSharedMemorySize, LDS_BYTES + 16); attr = true; }
  hipLaunchKernelGGL(k_phase<PH>, dim3(grid), dim3(NTHR), LDS_BYTES + 16, stream, p);
}
template <int PH> static void launch_range(const Params& p, int grid, hipStream_t stream, int last) {
  if (PH <= last) { launch_phase<PH>(p, grid, stream); if ((REP_MASK >> PH) & 1) launch_phase<PH>(p, grid, stream); }
  if constexpr (PH + 1 < NPHASE) launch_range<PH + 1>(p, grid, stream, last);
}

extern "C" void kernel_launch(void* const* d_in, const int* in_sizes, int n_in, void* d_out, int out_size, void* d_ws, size_t ws_size, hipStream_t stream) {
  static int grid = 0;
  if (!grid) {
    int dev = 0, cus = 0; hipGetDevice(&dev); hipDeviceGetAttribute(&cus, hipDeviceAttributeMultiprocessorCount, dev);
    if (cus <= 0) cus = 256;
    hipFuncSetAttribute((const void*)k_mega, hipFuncAttributeMaxDynamicSharedMemorySize, LDS_BYTES + 16);
    int per_cu = 0; hipOccupancyMaxActiveBlocksPerMultiprocessor(&per_cu, k_mega, NTHR, LDS_BYTES + 16);
    if (per_cu < 1) fprintf(stderr, "kernel_launch: occupancy query says %d blocks/CU\n", per_cu);
    grid = cus;
    if (ws_size < WS_END) fprintf(stderr, "kernel_launch: workspace too small: %zu < %zu\n", ws_size, WS_END);
  }
  Params p{};
  const float* const* in = (const float* const*)d_in;
  p.x = in[0]; p.pool_w = in[1]; p.pool_b = in[2]; p.pool_scale = in[3]; p.w_a = in[4]; p.qn_g = in[5]; p.kvn_g = in[6]; p.w_uq = in[7]; p.w_uk = in[8]; p.w_uv = in[9]; p.w_o = in[10];
  p.ln_mix_g = in[11]; p.ln_mix_b = in[12]; p.router_w = in[13]; p.router_b = in[14]; p.ew_gate = in[15]; p.ew_up = in[16]; p.ew_down = in[17];
  p.sw_gate = in[18]; p.sw_up = in[19]; p.sw_down = in[20]; p.ln_ffn_g = in[21]; p.ln_ffn_b = in[22];
  p.out = (float*)d_out; p.ws = (char*)d_ws;
  hipMemsetAsync((char*)d_ws + OFF_BAR, 0, 32768, stream);
#if MK_SINGLE
  hipLaunchKernelGGL(k_mega, dim3(grid), dim3(NTHR), LDS_BYTES + 16, stream, p);
#else
  launch_range<0>(p, grid, stream, NPHASE - 1);
#endif
#if DBG
  {
    char* ws = (char*)d_ws; float* err = (float*)(ws + OFF_DBG);
    const bf16_t* h0b = (const bf16_t*)(ws + OFF_H0B); const bf16_t* h1b = (const bf16_t*)(ws + OFF_H1B);
    chk_gemm<<<16, 256, 0, stream>>>(h0b, DM, p.router_w + (size_t)DM * NEXP, NEXP, DM, NEXP, (const float*)(ws + OFF_LOGIT), nullptr, NEXP, 0, p, err + 0, 0.5f);
    chk_route<<<16, 256, 0, stream>>>(p, 1, err + 1);
    chk_moe<<<72, 256, 0, stream>>>(p, 1, err + 2);
    chk_ln<<<4, 64, 0, stream>>>(p, nullptr, 1, (const float*)(ws + OFF_H0F), p.ln_ffn_g + DM, p.ln_ffn_b + DM, p.out, err + 3);
    chk_gemm<<<16, 256, 0, stream>>>(h1b, DM, p.w_a, WA_N, DM, WA_N, (const float*)(ws + OFF_ABUF), nullptr, WA_NP, 0, p, err + 4, 0.5f);
    chk_mla_rows<<<4, 64, 0, stream>>>(p, err + 5);
    chk_gemm<<<16, 256, 0, stream>>>((const bf16_t*)(ws + OFF_QLAT), QL, p.w_uq, 1536, QL, 1536, nullptr, (const bf16_t*)(ws + OFF_Q), 1536, 5, p, err + 6, 0.5f);
    chk_gemm<<<16, 256, 0, stream>>>((const bf16_t*)(ws + OFF_KVLAT), KVL, p.w_uk, 1024, KVL, 1024, nullptr, (const bf16_t*)(ws + OFF_K), 1536, 4, p, err + 7, 0.5f);
    chk_gemm<<<16, 256, 0, stream>>>((const bf16_t*)(ws + OFF_KVLAT), KVL, p.w_uv, 1024, KVL, 1024, nullptr, (const bf16_t*)(ws + OFF_V), 1024, 3, p, err + 8, 0.25f);
    chk_attn<<<64, 256, 0, stream>>>(p, err + 9);
    chk_gemm<<<16, 256, 0, stream>>>((const bf16_t*)(ws + OFF_O), DM, p.w_o, DM, DM, DM, (const float*)(ws + OFF_Z), nullptr, DM, 2, p, err + 10, 0.003f);
    chk_ln<<<4, 64, 0, stream>>>(p, (const float*)(ws + OFF_Z), 0, nullptr, p.ln_mix_g + DM, p.ln_mix_b + DM, (const float*)(ws + OFF_H0F), err + 11);
    dbg_report<<<256, 256, 0, stream>>>(err, 12, 0.03f, p.out, out_size);
  }
#endif
  const hipError_t le = hipPeekAtLastError();
  if (le != hipSuccess) fprintf(stderr, "kernel_launch: launch failed: %s\n", hipGetErrorName(le));
}
```

```cpp
#include <hip/hip_runtime.h>
#include <stdint.h>
#include <stdio.h>

#ifndef MK_SINGLE
#define MK_SINGLE 1
#endif
#ifndef DBG
#define DBG 0
#endif
#ifndef PROBE_T
#define PROBE_T 0
#endif
#ifndef PROBE_A0
#define PROBE_A0 11
#define PROBE_A1 12
#define PROBE_SCALE 0.2f
#endif
#define BENCH_MODE 2
#ifndef MOE_HACK
#define MOE_HACK 0
#endif
#ifndef REP_MASK
#define REP_MASK 0
#endif

constexpr int NTOK = 16384, DM = 1024, SEQ = 8192;
constexpr int NEXP = 256, EFF = 256, TOPK = 8;
constexpr int QL = 384, KVL = 256, NH = 8, DQK = 192, DNOPE = 128, DROPE = 64, DVH = 128;
constexpr int WA_N = 704, WA_NP = 768;
constexpr float ALPHA = 1.4142135623730951f;
constexpr float LN_EPS = 1e-5f, RMS_EPS = 1e-6f;
constexpr int NTHR = 512;

typedef unsigned short bf16_t;
typedef __attribute__((ext_vector_type(8))) short bf16x8;
typedef __attribute__((ext_vector_type(4))) short s16x4;
typedef __attribute__((ext_vector_type(16))) float f32x16;
typedef __attribute__((ext_vector_type(4))) float f32x4;
typedef __attribute__((ext_vector_type(2))) float f32x2;
typedef __attribute__((ext_vector_type(4))) unsigned u32x4;
typedef __attribute__((ext_vector_type(2))) unsigned u32x2;

constexpr size_t al256(size_t x) { return (x + 255) / 256 * 256; }
constexpr size_t OFF_BAR = 0;
constexpr size_t OFF_DBG = 16384;
constexpr size_t OFF_CNT = 32768;
constexpr int CNT_STRIDE = 32;
constexpr size_t OFF_ROPE = 65536;
constexpr size_t OFF_WPOOL = OFF_ROPE + 2 * (size_t)SEQ * 32 * 4;
constexpr size_t OFF_WR = OFF_WPOOL + (size_t)4 * 256 * 256 * 2;
constexpr size_t OFF_WA = OFF_WR + (size_t)2 * DM * NEXP * 2;
constexpr size_t OFF_WUQ = OFF_WA + (size_t)DM * WA_NP * 2;
constexpr size_t OFF_WUK = OFF_WUQ + (size_t)QL * 1536 * 2;
constexpr size_t OFF_WUV = OFF_WUK + (size_t)KVL * 1024 * 2;
constexpr size_t OFF_WO = OFF_WUV + (size_t)KVL * 1024 * 2;
constexpr size_t OFF_SWG = OFF_WO + (size_t)DM * DM * 2;
constexpr size_t OFF_SWU = OFF_SWG + (size_t)2 * DM * EFF * 2;
constexpr size_t OFF_SWD = OFF_SWU + (size_t)2 * DM * EFF * 2;
constexpr size_t OFF_POOLED = OFF_SWD + (size_t)2 * EFF * DM * 2;
constexpr size_t OFF_Z = OFF_POOLED + (size_t)NTOK * DM * 2;
constexpr size_t OFF_H0F = OFF_Z + (size_t)NTOK * DM * 4;
constexpr size_t OFF_CNTP = OFF_H0F;
constexpr size_t OFF_GLIST = OFF_H0F + (1u << 20);
constexpr size_t OFF_H0B = OFF_H0F + (size_t)NTOK * DM * 4;
constexpr size_t OFF_H1F = OFF_H0B + (size_t)NTOK * DM * 2;
constexpr size_t OFF_H1B = OFF_H1F + (size_t)NTOK * DM * 4;
constexpr size_t OFF_LOGIT = OFF_H1B + (size_t)NTOK * DM * 2;
constexpr size_t OFF_LIST = OFF_LOGIT + (size_t)NTOK * NEXP * 4;
constexpr size_t OFF_GATE = OFF_LIST + (size_t)NEXP * NTOK * 4;
constexpr size_t OFF_TEXP = OFF_GATE + (size_t)NTOK * TOPK * 4;
constexpr size_t OFF_Y = OFF_TEXP + (size_t)NTOK * TOPK * 4;
constexpr size_t OFF_YSH = OFF_Y + (size_t)NTOK * TOPK * DM * 2;
constexpr size_t OFF_ABUF = OFF_YSH + (size_t)NTOK * DM * 2;
constexpr size_t OFF_QLAT = OFF_ABUF + (size_t)NTOK * WA_NP * 4;
constexpr size_t OFF_KVLAT = OFF_QLAT + (size_t)NTOK * QL * 2;
constexpr size_t OFF_Q = OFF_KVLAT + (size_t)NTOK * KVL * 2;
constexpr size_t OFF_K = OFF_Q + (size_t)NTOK * 1536 * 2;
constexpr size_t OFF_V = OFF_K + (size_t)NTOK * 1536 * 2;
constexpr size_t OFF_O = OFF_V + (size_t)NTOK * 1024 * 2;
constexpr size_t WS_END = OFF_O + (size_t)NTOK * 1024 * 2;

struct Params {
  const float *x, *pool_w, *pool_b, *pool_scale, *w_a, *qn_g, *kvn_g, *w_uq, *w_uk, *w_uv, *w_o;
  const float *ln_mix_g, *ln_mix_b, *router_w, *router_b, *ew_gate, *ew_up, *ew_down, *sw_gate, *sw_up, *sw_down, *ln_ffn_g, *ln_ffn_b;
  float* out;
  char* ws;
};

#define XB_TMO      128
#define XB_XCNT(j)  (256  + 64 * (j))
#define XB_XSUB(j)  (1280 + 64 * (j))
#define XB_XGEN(j)  (2304 + 64 * (j))
#define XB_TOP      3328
#define XB_TOPGEN   3392
#define XCD_BAR_WORDS 3456
#define XB_SPIN_CAP (1u << 20)
#define LAS __attribute__((address_space(3)))

__device__ __forceinline__ unsigned xb_ld(unsigned* p)              { return __hip_atomic_load(p, __ATOMIC_RELAXED, __HIP_MEMORY_SCOPE_AGENT); }
__device__ __forceinline__ unsigned xb_add(unsigned* p, unsigned v) { return __hip_atomic_fetch_add(p, v, __ATOMIC_RELAXED, __HIP_MEMORY_SCOPE_AGENT); }
__device__ __forceinline__ unsigned xb_xcc_id() { return (unsigned)__builtin_amdgcn_s_getreg((3 << 11) | 20) & 0xFu; }
#define XB_SPIN(cond, bar) do { unsigned _sp = 0; while (cond) { __builtin_amdgcn_s_sleep(1); \
    if ((++_sp & 255u) == 0u) { if (xb_ld(&(bar)[XB_TMO])) break; if (_sp > XB_SPIN_CAP) { atomicAdd(&(bar)[XB_TMO], 1u); break; } } } } while (0)

struct XcdBarrier { unsigned* bar; unsigned x; volatile LAS unsigned* st; };

__device__ __forceinline__ XcdBarrier xcd_barrier_post(unsigned* bar, volatile LAS unsigned* st) {
    XcdBarrier b; b.bar = bar; b.x = xb_xcc_id(); b.st = st;
    if (threadIdx.x == 0) (void)xb_add(&bar[XB_XCNT(b.x)], 1u);
    return b;
}
__device__ __forceinline__ void xcd_barrier_complete(unsigned* bar, unsigned x, unsigned& nloc, unsigned& nx) {
    const unsigned G = gridDim.x * gridDim.y * gridDim.z;
    unsigned sum, cnt, mine, sp = 0u;
    for (;;) {
        sum = 0u; cnt = 0u; mine = 0u;
#pragma unroll
        for (unsigned j = 0; j < 16; ++j) { const unsigned c = xb_ld(&bar[XB_XCNT(j)]); sum += c; cnt += (c > 0u) ? 1u : 0u; mine = (j == x) ? c : mine; }
        if (sum == G) break;
        __builtin_amdgcn_s_sleep(1);
        if ((++sp & 255u) == 0u) { if (xb_ld(&bar[XB_TMO])) break; if (sp > XB_SPIN_CAP) { atomicAdd(&bar[XB_TMO], 1u); break; } }
    }
    nloc = mine > 0u ? mine : 1u; nx = cnt > 0u ? cnt : 1u;
}
__device__ __forceinline__ void xcd_barrier(const XcdBarrier& b) {
    asm volatile("s_waitcnt vmcnt(0)" ::: "memory");
    __syncthreads();
    if (threadIdx.x == 0) {
        unsigned* bar = b.bar;
        __builtin_amdgcn_s_waitcnt(0);
        unsigned nloc = b.st[0], nx = b.st[1];
        if (nloc == 0u) { xcd_barrier_complete(bar, b.x, nloc, nx); b.st[0] = nloc; b.st[1] = nx; }
        const unsigned old = xb_add(&bar[XB_XSUB(b.x)], 1u);
        const unsigned gen = old / nloc;
        if (old + 1u == (gen + 1u) * nloc) {
            __builtin_amdgcn_fence(__ATOMIC_RELEASE, "agent");
            asm volatile("s_waitcnt vmcnt(0)" ::: "memory");
            const unsigned og = xb_add(&bar[XB_TOP], 1u);
            const unsigned tg = og / nx;
            if (og + 1u == (tg + 1u) * nx) xb_add(&bar[XB_TOPGEN], 1u);
            else XB_SPIN(xb_ld(&bar[XB_TOPGEN]) == tg, bar);
            __builtin_amdgcn_fence(__ATOMIC_ACQUIRE, "agent");
            xb_add(&bar[XB_XGEN(b.x)], 1u);
            asm volatile("s_waitcnt vmcnt(0)" ::: "memory");
        } else {
            XB_SPIN(xb_ld(&bar[XB_XGEN(b.x)]) == gen, bar);
            __builtin_amdgcn_fence(__ATOMIC_ACQUIRE, "agent");
            asm volatile("s_waitcnt vmcnt(0)" ::: "memory");
        }
    }
    __syncthreads();
}


constexpr size_t OFF_XCENSUS = 17408;
constexpr size_t OFF_RBAR = 18432;
struct Deal { int xg, rk, ng, ngroups; bool census; };
__device__ __forceinline__ Deal get_deal(const Params& p, const char* lds_end_words) {
  const unsigned* w = reinterpret_cast<const unsigned*>(lds_end_words);
  const unsigned myx = w[2], myr = w[3];
  Deal d;
  if (myx == ~0u) { d.xg = blockIdx.x & 7; d.rk = blockIdx.x >> 3; d.ng = ((int)gridDim.x + 7 - d.xg) >> 3; d.ngroups = 8; d.census = false; return d; }
  unsigned* cen = (unsigned*)(p.ws + OFF_XCENSUS);
  int ngroups = 0, xg = 0, ng = 1;
#pragma unroll
  for (int j = 0; j < 16; ++j) { const unsigned c = xb_ld(&cen[j]); ngroups += c > 0u; xg += (c > 0u && (unsigned)j < myx); if ((unsigned)j == myx) ng = (int)c; }
  d.xg = __builtin_amdgcn_readfirstlane(xg); d.rk = __builtin_amdgcn_readfirstlane((int)myr); d.ng = __builtin_amdgcn_readfirstlane(ng); d.ngroups = __builtin_amdgcn_readfirstlane(ngroups); d.census = true;
  return d;
}
__device__ __forceinline__ void round_barrier(const Params& p, const char* lds_end_words, int layer, int round, int ng) {
  __syncthreads();
  if (threadIdx.x == 0) {
    const unsigned myx = reinterpret_cast<const unsigned*>(lds_end_words)[2];
    unsigned* wd = (unsigned*)(p.ws + OFF_RBAR) + (layer * 16 + (int)myx) * 16;
    xb_add(wd, 1u);
    const unsigned target = (unsigned)((round + 1) * ng);
    unsigned sp = 0;
    while (xb_ld(wd) < target) { __builtin_amdgcn_s_sleep(2); if (++sp > (1u << 16)) break; }
  }
  __syncthreads();
}

__device__ __forceinline__ int opaque_tid() { int t = threadIdx.x; asm volatile("" : "+v"(t)); return t; }
#define SBAR() __builtin_amdgcn_sched_barrier(0)
__device__ __forceinline__ int crow(int r, int hi) { return (r & 3) + 8 * (r >> 2) + 4 * hi; }
__device__ __forceinline__ unsigned cvtpk(float lo, float hi) {
  unsigned r; asm("v_cvt_pk_bf16_f32 %0, %1, %2" : "=v"(r) : "v"(lo), "v"(hi)); return r;
}
__device__ __forceinline__ bf16_t f2bf(float f) { return (bf16_t)(cvtpk(f, 0.f) & 0xffffu); }
__device__ __forceinline__ float bf2f(bf16_t b) { return __uint_as_float(((unsigned)b) << 16); }
__device__ __forceinline__ bf16x8 cvt8(f32x4 a, f32x4 b) {
  u32x4 w = {cvtpk(a[0], a[1]), cvtpk(a[2], a[3]), cvtpk(b[0], b[1]), cvtpk(b[2], b[3])};
  return *reinterpret_cast<bf16x8*>(&w);
}
template <int CTRL> __device__ __forceinline__ float dppf(float v) { return __int_as_float(__builtin_amdgcn_update_dpp(0, __float_as_int(v), CTRL, 0xf, 0xf, false)); }
constexpr int DPP_XOR1 = 0xB1, DPP_XOR2 = 0x4E, DPP_HALF_MIRROR = 0x141, DPP_MIRROR = 0x140;
__device__ __forceinline__ float rdlane(float v, int l) { return __int_as_float(__builtin_amdgcn_readlane(__float_as_int(v), l)); }
__device__ __forceinline__ float wave_sum(float v) {
  v += dppf<DPP_XOR1>(v); v += dppf<DPP_XOR2>(v); v += dppf<DPP_HALF_MIRROR>(v); v += dppf<DPP_MIRROR>(v);
  return (rdlane(v, 0) + rdlane(v, 16)) + (rdlane(v, 32) + rdlane(v, 48));
}
__device__ __forceinline__ float wave_max(float v) {
  v = fmaxf(v, dppf<DPP_XOR1>(v)); v = fmaxf(v, dppf<DPP_XOR2>(v)); v = fmaxf(v, dppf<DPP_HALF_MIRROR>(v)); v = fmaxf(v, dppf<DPP_MIRROR>(v));
  return fmaxf(fmaxf(rdlane(v, 0), rdlane(v, 16)), fmaxf(rdlane(v, 32), rdlane(v, 48)));
}

template <int BK> __device__ __forceinline__ int a_off(int row, int chunk) {
  if (BK == 32) return row * 64 + ((chunk ^ ((row >> 2) & 3)) << 4);
  else          return row * 128 + ((chunk ^ ((row >> 1) & 7)) << 4);
}
__device__ __forceinline__ int hb_off(int row, int chunk) { return row * 512 + ((chunk ^ (row & 15)) << 4); }
template <int BN> __device__ __forceinline__ int b_st_off(int k, int c) {
  const int kk = (k & ~0xC) | ((k & 4) << 1) | ((k & 8) >> 1);
  return ((kk >> 3) * (BN / 32) + (c >> 5)) * 512 + ((kk & 7) * 32 + (c & 31)) * 2;
}
__device__ __forceinline__ int v_rd_base(int lane) { return ((lane & 3) << 3) | (((lane >> 2) & 3) << 6) | (((lane >> 4) & 1) << 5) | (((lane >> 5) & 1) << 8); }
template <int OFF> __device__ __forceinline__ s16x4 tr_read(int addr) {
  s16x4 r; asm volatile("ds_read_b64_tr_b16 %0, %1 offset:%2" : "=&v"(r) : "v"(addr), "i"(OFF) : "memory"); return r;
}
#define PKF(L, H) (bf16x8){L[0], L[1], L[2], L[3], H[0], H[1], H[2], H[3]}

template <int BN, int BK> struct GC {
  static constexpr int NB = BN / 128;
  static constexpr int CH = BK / 8;
  static constexpr int A_BYTES = 128 * BK * 2;
  static constexpr int B_BYTES = BK * BN * 2;
  static constexpr int STAGE = A_BYTES + B_BYTES;
  static constexpr int BP = BK * BN / 4096;
  static constexpr int AP = 128 * CH / 512;
  static constexpr int CPR = BN / 8;
  static constexpr int RSTEP = 512 / CPR;
};

template <int BN, int S, bool SWAP, bool DUAL, class MID>
__device__ __forceinline__ void kstep(f32x16 (&acc)[2][BN / 128], bf16x8 a0, bf16x8 a1, int bb0, int bb1, MID&& mid) {
  constexpr int NB = BN / 128;
  constexpr int RS = (BN / 32) * 512;
  constexpr int O0 = (2 * S) * RS, O1 = (2 * S + 1) * RS;
  bf16x8 bf[2];
  if constexpr (NB == 2) {
    s16x4 l0 = tr_read<O0>(bb0), h0 = tr_read<O1>(bb0), l1 = tr_read<O0 + 512>(bb0), h1 = tr_read<O1 + 512>(bb0);
    asm volatile("s_waitcnt lgkmcnt(0)" ::: "memory"); SBAR();
    bf[0] = PKF(l0, h0); bf[1] = PKF(l1, h1);
  } else {
    {
      s16x4 l0 = tr_read<O0>(bb0), h0 = tr_read<O1>(bb0), l1 = tr_read<O0 + 512>(bb0), h1 = tr_read<O1 + 512>(bb0);
      asm volatile("s_waitcnt lgkmcnt(0)" ::: "memory"); SBAR();
      bf[0] = PKF(l0, h0); bf[1] = PKF(l1, h1);
    }
#pragma unroll
    for (int j = 0; j < 2; ++j) {
      if constexpr (SWAP) {
        acc[0][j] = __builtin_amdgcn_mfma_f32_32x32x16_bf16(bf[j], a0, acc[0][j], 0, 0, 0);
        acc[1][j] = __builtin_amdgcn_mfma_f32_32x32x16_bf16(bf[j], a1, acc[1][j], 0, 0, 0);
      } else {
        acc[0][j] = __builtin_amdgcn_mfma_f32_32x32x16_bf16(a0, bf[j], acc[0][j], 0, 0, 0);
        acc[1][j] = __builtin_amdgcn_mfma_f32_32x32x16_bf16(a1, bf[j], acc[1][j], 0, 0, 0);
      }
    }
    mid(2 * S);
    {
      s16x4 l2, h2, l3, h3;
      if constexpr (DUAL) { l2 = tr_read<O0>(bb1); h2 = tr_read<O1>(bb1); l3 = tr_read<O0 + 512>(bb1); h3 = tr_read<O1 + 512>(bb1); }
      else { l2 = tr_read<O0 + 1024>(bb0); h2 = tr_read<O1 + 1024>(bb0); l3 = tr_read<O0 + 1536>(bb0); h3 = tr_read<O1 + 1536>(bb0); }
      asm volatile("s_waitcnt lgkmcnt(0)" ::: "memory"); SBAR();
      bf[0] = PKF(l2, h2); bf[1] = PKF(l3, h3);
    }
#pragma unroll
    for (int j = 0; j < 2; ++j) {
      if constexpr (SWAP) {
        acc[0][j + 2] = __builtin_amdgcn_mfma_f32_32x32x16_bf16(bf[j], a0, acc[0][j + 2], 0, 0, 0);
        acc[1][j + 2] = __builtin_amdgcn_mfma_f32_32x32x16_bf16(bf[j], a1, acc[1][j + 2], 0, 0, 0);
      } else {
        acc[0][j + 2] = __builtin_amdgcn_mfma_f32_32x32x16_bf16(a0, bf[j], acc[0][j + 2], 0, 0, 0);
        acc[1][j + 2] = __builtin_amdgcn_mfma_f32_32x32x16_bf16(a1, bf[j], acc[1][j + 2], 0, 0, 0);
      }
    }
    mid(2 * S + 1);
    return;
  }
#pragma unroll
  for (int j = 0; j < 2; ++j) {
    if constexpr (SWAP) {
      acc[0][j] = __builtin_amdgcn_mfma_f32_32x32x16_bf16(bf[j], a0, acc[0][j], 0, 0, 0);
      acc[1][j] = __builtin_amdgcn_mfma_f32_32x32x16_bf16(bf[j], a1, acc[1][j], 0, 0, 0);
    } else {
      acc[0][j] = __builtin_amdgcn_mfma_f32_32x32x16_bf16(a0, bf[j], acc[0][j], 0, 0, 0);
      acc[1][j] = __builtin_amdgcn_mfma_f32_32x32x16_bf16(a1, bf[j], acc[1][j], 0, 0, 0);
    }
  }
  mid(S);
}

template <int BN, int BK, bool SWAP, bool AHB, bool DUAL, typename TB, int PF = 1>
__device__ __forceinline__ void gemm_core(f32x16 (&acc)[2][BN / 128], const char* abase, unsigned aoff0, unsigned aoff1,
                                          const char* bbase, unsigned boff, unsigned ldbB, int bk0, int bc, int NT, char* stage, const char* hb, const u32x4* pre = nullptr, const u32x4* pre_a = nullptr) {
  using C = GC<BN, BK>;
  constexpr bool BF32 = sizeof(TB) == 4;
  constexpr int ABYTES = AHB ? 0 : C::A_BYTES;
  constexpr int STG = ABYTES + C::B_BYTES;
  constexpr int NBR = BF32 ? BK * BN / 2048 : C::BP;
  const int tid = opaque_tid(), lane = tid & 63, wid = tid >> 6, r32 = lane & 31, hi = lane >> 5;
  const int wm = wid >> 2, wn = wid & 3;
  int ast0 = 0, ast1 = 0;
  if constexpr (!AHB) { ast0 = a_off<BK>(tid / C::CH, tid % C::CH); if constexpr (C::AP == 2) ast1 = a_off<BK>((512 + tid) / C::CH, (512 + tid) % C::CH); }
  const int row0 = wm * 64 + r32, row1 = row0 + 32;
  int bb0, bb1;
  if constexpr (DUAL) { bb0 = v_rd_base(lane) + (2 * wn) * 512; bb1 = v_rd_base(lane) + (8 + 2 * wn) * 512; }
  else { bb0 = v_rd_base(lane) + (wn * C::NB) * 512; bb1 = bb0; }
  const int sbase = (int)(uintptr_t)stage;
  bb0 += sbase + ABYTES; bb1 += sbase + ABYTES;

  struct Regs { u32x4 a[C::AP]; u32x4 b[NBR]; };
  auto gload = [&](Regs& R, int kt) {
    if constexpr (!AHB) {
      const char* ab = abase + (size_t)kt * (BK * 2);
      R.a[0] = *reinterpret_cast<const u32x4*>(ab + aoff0);
      if constexpr (C::AP == 2) R.a[1] = *reinterpret_cast<const u32x4*>(ab + aoff1);
    }
    const char* bb = bbase + (size_t)kt * BK * ldbB;
    if constexpr (BF32) {
#pragma unroll
      for (int i = 0; i < NBR; ++i) R.b[i] = *reinterpret_cast<const u32x4*>(bb + (size_t)i * ldbB + boff);
    } else {
#pragma unroll
      for (int i = 0; i < C::BP; ++i) R.b[i] = *reinterpret_cast<const u32x4*>(bb + (size_t)(i * C::RSTEP) * ldbB + boff);
    }
  };
  constexpr int NL = (AHB ? 0 : C::AP) + NBR;
  auto gload_one = [&](Regs& R, int kt, int l) {
    if (!AHB && l < C::AP) { const char* ab = abase + (size_t)kt * (BK * 2); R.a[l] = *reinterpret_cast<const u32x4*>(ab + (l == 0 ? aoff0 : aoff1)); }
    else { const int i = l - (AHB ? 0 : C::AP); const char* bb = bbase + (size_t)kt * BK * ldbB;
      if constexpr (BF32) R.b[i] = *reinterpret_cast<const u32x4*>(bb + (size_t)i * ldbB + boff);
      else R.b[i] = *reinterpret_cast<const u32x4*>(bb + (size_t)(i * C::RSTEP) * ldbB + boff); }
  };
  auto swrite_one = [&](Regs& R, int buf, int l) {
    char* s = stage + buf * STG;
    if (!AHB && l < C::AP) { *reinterpret_cast<u32x4*>(s + (l == 0 ? ast0 : ast1)) = R.a[l]; }
    else { const int i = l - (AHB ? 0 : C::AP);
      if constexpr (BF32) { const f32x4 v = *reinterpret_cast<f32x4*>(&R.b[i]);
        u32x2 w = {cvtpk(v[0], v[1]), cvtpk(v[2], v[3])};
        *reinterpret_cast<u32x2*>(s + ABYTES + b_st_off<BN>(bk0 + i, bc)) = w; }
      else *reinterpret_cast<u32x4*>(s + ABYTES + b_st_off<BN>(bk0 + i * C::RSTEP, bc)) = R.b[i]; }
  };
  auto swrite = [&](Regs& R, int buf) {
    char* s = stage + buf * STG;
    if constexpr (!AHB) {
      *reinterpret_cast<u32x4*>(s + ast0) = R.a[0];
      if constexpr (C::AP == 2) *reinterpret_cast<u32x4*>(s + ast1) = R.a[1];
    }
    if constexpr (BF32) {
#pragma unroll
      for (int i = 0; i < NBR; ++i) {
        const f32x4 v = *reinterpret_cast<f32x4*>(&R.b[i]);
        u32x2 w = {cvtpk(v[0], v[1]), cvtpk(v[2], v[3])};
        *reinterpret_cast<u32x2*>(s + ABYTES + b_st_off<BN>(bk0 + i, bc)) = w;
      }
    } else {
#pragma unroll
      for (int i = 0; i < C::BP; ++i) *reinterpret_cast<u32x4*>(s + ABYTES + b_st_off<BN>(bk0 + i * C::RSTEP, bc)) = R.b[i];
    }
  };
  auto compute = [&](int kt, int cur, Regs* Rn, int ktn) {
    const char* As = stage + cur * STG;
    const int b0 = bb0 + cur * STG, b1 = bb1 + cur * STG;
    auto mid = [&](int g) {
      if (Rn) {
#pragma unroll
        for (int l = 0; l < NL; ++l) if ((l & 3) == (g & 3)) swrite_one(*Rn, cur ^ 1, l);
#pragma unroll
        for (int l = 0; l < NL; ++l) if ((l & 3) == (g & 3)) gload_one(*Rn, ktn, l);
        SBAR();
      }
    };
#define KSTEP(S)                                                                                                   \
    do { bf16x8 a0, a1;                                                                                            \
      if constexpr (AHB) { const int ch = kt * (BK / 8) + (S) * 2 + hi;                                            \
        a0 = *reinterpret_cast<const bf16x8*>(hb + hb_off(row0, ch)); a1 = *reinterpret_cast<const bf16x8*>(hb + hb_off(row1, ch)); } \
      else { a0 = *reinterpret_cast<const bf16x8*>(As + a_off<BK>(row0, (S) * 2 + hi)); a1 = *reinterpret_cast<const bf16x8*>(As + a_off<BK>(row1, (S) * 2 + hi)); } \
      kstep<BN, S, SWAP, DUAL>(acc, a0, a1, b0, b1, mid); } while (0)
    KSTEP(0); KSTEP(1);
    if constexpr (BK == 64) { KSTEP(2); KSTEP(3); }
#undef KSTEP
  };
  auto compute_p = [&](int kt, int cur, Regs& R, const int mode, u32x4* aw = nullptr, const bool aload = false) {
    const char* As = stage + cur * STG;
    const int b0 = bb0 + cur * STG, b1 = bb1 + cur * STG;
    auto trd = [&](int addr) { return __builtin_amdgcn_ds_read_tr16_b64_v4i16((LAS s16x4*)(size_t)(unsigned)addr); };
    auto rdA = [&](int S, bf16x8& a0, bf16x8& a1) {
      if constexpr (AHB) { const int ch = kt * (BK / 8) + S * 2 + hi;
        a0 = *reinterpret_cast<const bf16x8*>(hb + hb_off(row0, ch)); a1 = *reinterpret_cast<const bf16x8*>(hb + hb_off(row1, ch)); }
      else { a0 = *reinterpret_cast<const bf16x8*>(As + a_off<BK>(row0, S * 2 + hi)); a1 = *reinterpret_cast<const bf16x8*>(As + a_off<BK>(row1, S * 2 + hi)); }
    };
    auto rdB = [&](int S, int H, bf16x8& f0, bf16x8& f1) {
      constexpr int RS = (BN / 32) * 512;
      const int o0 = (2 * S) * RS, o1 = (2 * S + 1) * RS;
      const int base = (H == 0) ? b0 : (DUAL ? b1 : b0 + 1024);
      const s16x4 l0 = trd(base + o0), h0 = trd(base + o1), l1 = trd(base + o0 + 512), h1 = trd(base + o1 + 512);
      f0 = PKF(l0, h0); f1 = PKF(l1, h1);
    };
    auto mm = [&](int H, bf16x8 a0, bf16x8 a1, bf16x8 f0, bf16x8 f1) {
      if constexpr (SWAP) {
        acc[0][2 * H] = __builtin_amdgcn_mfma_f32_32x32x16_bf16(f0, a0, acc[0][2 * H], 0, 0, 0);
        acc[1][2 * H] = __builtin_amdgcn_mfma_f32_32x32x16_bf16(f0, a1, acc[1][2 * H], 0, 0, 0);
        acc[0][2 * H + 1] = __builtin_amdgcn_mfma_f32_32x32x16_bf16(f1, a0, acc[0][2 * H + 1], 0, 0, 0);
        acc[1][2 * H + 1] = __builtin_amdgcn_mfma_f32_32x32x16_bf16(f1, a1, acc[1][2 * H + 1], 0, 0, 0);
      } else {
        acc[0][2 * H] = __builtin_amdgcn_mfma_f32_32x32x16_bf16(a0, f0, acc[0][2 * H], 0, 0, 0);
        acc[1][2 * H] = __builtin_amdgcn_mfma_f32_32x32x16_bf16(a1, f0, acc[1][2 * H], 0, 0, 0);
        acc[0][2 * H + 1] = __builtin_amdgcn_mfma_f32_32x32x16_bf16(a0, f1, acc[0][2 * H + 1], 0, 0, 0);
        acc[1][2 * H + 1] = __builtin_amdgcn_mfma_f32_32x32x16_bf16(a1, f1, acc[1][2 * H + 1], 0, 0, 0);
      }
    };
    auto mid = [&](int g) {
      if (mode & 1) {
#pragma unroll
        for (int l = 0; l < NL; ++l) if ((l & 3) == g) {
          if (!AHB && aw && l == 0) *reinterpret_cast<u32x4*>(stage + (cur ^ 1) * STG + ast0) = *aw;
          else swrite_one(R, cur ^ 1, l);
        }
      }
      if (!AHB && aw) { if (g == 0 && aload) *aw = *reinterpret_cast<const u32x4*>(abase + (size_t)(kt + 3) * (BK * 2) + aoff0); }
      if (mode & 2) {
#pragma unroll
        for (int l = 0; l < NL; ++l) if ((l & 3) == g) { if (!AHB && aw && l == 0) continue; gload_one(R, kt + 2, l); }
      }
    };
    bf16x8 a0, a1, c0, c1, p0, p1, q0, q1;
    rdA(0, a0, a1); rdB(0, 0, p0, p1);
    rdB(0, 1, q0, q1); SBAR();
    mm(0, a0, a1, p0, p1); SBAR(); mid(0); SBAR();
    rdA(1, c0, c1); rdB(1, 0, p0, p1); SBAR();
    mm(1, a0, a1, q0, q1); SBAR(); mid(1); SBAR();
    rdB(1, 1, q0, q1); SBAR();
    mm(0, c0, c1, p0, p1); SBAR(); mid(2); SBAR();
    mm(1, c0, c1, q0, q1); SBAR(); mid(3); SBAR();
  };
  if constexpr (PF == 1) {
    Regs R;
    gload(R, 0);
    swrite(R, 0);
    if (NT > 1) gload(R, 1);
    __syncthreads();
#pragma unroll 1
    for (int kt = 0; kt < NT; ++kt) {
      const int cur = kt & 1;
      if (kt + 1 < NT) swrite(R, cur ^ 1);
      if (kt + 2 < NT) gload(R, kt + 2);
      compute(kt, cur, nullptr, 0);
      __syncthreads();
    }
  } else if constexpr (PF == 3) {
    static_assert(BN == 512 && BK == 32, "pipelined form");
    Regs R;
    if (pre) {
      static_assert(true, "");
#pragma unroll
      for (int i = 0; i < NBR; ++i) R.b[i] = pre[i];
      if constexpr (!AHB) { static_assert(AHB || C::AP == 1, "one A piece"); R.a[0] = pre_a[0]; }
    } else gload(R, 0);
    swrite(R, 0);
#pragma unroll
    for (int g = 0; g < 4; ++g) {
#pragma unroll
      for (int l = 0; l < NL; ++l) if ((l & 3) == g) { gload_one(R, 1, l); SBAR(); }
    }
    if constexpr (!AHB) {
      u32x4 a0s = *reinterpret_cast<const u32x4*>(abase + (size_t)2 * (BK * 2) + aoff0);
      u32x4 a1s = R.a[0];
      __syncthreads();
      int kt = 0;
#pragma unroll 1
      for (; kt + 4 < NT; kt += 2) {
        compute_p(kt, 0, R, 3, &a1s, true); __syncthreads();
        compute_p(kt + 1, 1, R, 3, &a0s, true); __syncthreads();
      }
      compute_p(kt, 0, R, 3, &a1s, true); __syncthreads();
      compute_p(kt + 1, 1, R, 3, &a0s, false); __syncthreads();
      compute_p(kt + 2, 0, R, 1, &a1s, false); __syncthreads();
      compute_p(kt + 3, 1, R, 0, &a0s, false); __syncthreads();
    } else {
    __syncthreads();
    int kt = 0;
#pragma unroll 1
    for (; kt + 2 < NT; ++kt) { compute_p(kt, kt & 1, R, 3); __syncthreads(); }
    compute_p(kt, kt & 1, R, 1); __syncthreads();
    ++kt;
    compute_p(kt, kt & 1, R, 0); __syncthreads();
    }
  } else {
    Regs R0, R1;
    gload(R0, 0); gload(R1, 1);
    swrite(R0, 0);
    gload(R0, 2);
    __syncthreads();
    int kt = 0;
#pragma unroll 1
    for (; kt + 4 < NT; kt += 2) {
      compute(kt, 0, &R1, kt + 3); __syncthreads();
      compute(kt + 1, 1, &R0, kt + 4); __syncthreads();
    }
    swrite(R1, 1); gload(R1, kt + 3); compute(kt, 0, nullptr, 0); __syncthreads();
    swrite(R0, 0); compute(kt + 1, 1, nullptr, 0); __syncthreads();
    swrite(R1, 1); compute(kt + 2, 0, nullptr, 0); __syncthreads();
    compute(kt + 3, 1, nullptr, 0); __syncthreads();
  }
}

template <int MB, bool SWAP, bool AHB>
__device__ __forceinline__ void gemm_rs(f32x16 (&acc)[MB][2], const char* abase, unsigned aoff0, unsigned aoff1,
                                        const char* bstream, int KSS, int NT, char* stage, const char* hb, int rowbase) {
  const int tid = opaque_tid(), lane = tid & 63, r32 = lane & 31, hi = lane >> 5;
  const int ast0 = a_off<64>(tid >> 3, tid & 7), ast1 = a_off<64>(64 + (tid >> 3), tid & 7);
  const char* bl = bstream + lane * 16;
  bf16x8 bq[8][2];
  u32x4 ar0 = {0, 0, 0, 0}, ar1 = {0, 0, 0, 0};
  if constexpr (!AHB) { ar0 = *reinterpret_cast<const u32x4*>(abase + aoff0); ar1 = *reinterpret_cast<const u32x4*>(abase + aoff1); }
#pragma unroll
  for (int s2 = 0; s2 < 8; ++s2) { const int k0 = s2 < NT * 4 ? s2 : NT * 4 - 1; bq[s2][0] = *reinterpret_cast<const bf16x8*>(bl + (size_t)k0 * KSS); bq[s2][1] = *reinterpret_cast<const bf16x8*>(bl + (size_t)k0 * KSS + 1024); }
  if constexpr (!AHB) {
    *reinterpret_cast<u32x4*>(stage + ast0) = ar0; *reinterpret_cast<u32x4*>(stage + ast1) = ar1;
    ar0 = *reinterpret_cast<const u32x4*>(abase + (size_t)128 + aoff0); ar1 = *reinterpret_cast<const u32x4*>(abase + (size_t)128 + aoff1);
    __syncthreads();
  }
  const int lastks = NT * 4 - 1;
#pragma unroll 1
  for (int kt = 0; kt < NT; kt += 2) {
#pragma unroll
    for (int half = 0; half < 2; ++half) {
      const char* As = stage + half * 16384;
#pragma unroll
      for (int s2 = 0; s2 < 4; ++s2) {
        bf16x8 af[MB];
#pragma unroll
        for (int i = 0; i < MB; ++i) {
          if constexpr (AHB) af[i] = *reinterpret_cast<const bf16x8*>(hb + hb_off(rowbase + i * 32 + r32, ((kt + half) * 4 + s2) * 2 + hi));
          else af[i] = *reinterpret_cast<const bf16x8*>(As + a_off<64>(rowbase + i * 32 + r32, s2 * 2 + hi));
        }
        const bf16x8 b0 = bq[half * 4 + s2][0], b1 = bq[half * 4 + s2][1];
        int ksn = (kt + half + 2) * 4 + s2; ksn = ksn < lastks ? ksn : lastks;
        bq[half * 4 + s2][0] = *reinterpret_cast<const bf16x8*>(bl + (size_t)ksn * KSS); bq[half * 4 + s2][1] = *reinterpret_cast<const bf16x8*>(bl + (size_t)ksn * KSS + 1024);
#pragma unroll
        for (int i = 0; i < MB; ++i) {
          if constexpr (SWAP) {
            acc[i][0] = __builtin_amdgcn_mfma_f32_32x32x16_bf16(b0, af[i], acc[i][0], 0, 0, 0);
            acc[i][1] = __builtin_amdgcn_mfma_f32_32x32x16_bf16(b1, af[i], acc[i][1], 0, 0, 0);
          } else {
            acc[i][0] = __builtin_amdgcn_mfma_f32_32x32x16_bf16(af[i], b0, acc[i][0], 0, 0, 0);
            acc[i][1] = __builtin_amdgcn_mfma_f32_32x32x16_bf16(af[i], b1, acc[i][1], 0, 0, 0);
          }
        }
      }
      if constexpr (!AHB) {
        char* sn = stage + (half ^ 1) * 16384;
        *reinterpret_cast<u32x4*>(sn + ast0) = ar0; *reinterpret_cast<u32x4*>(sn + ast1) = ar1;
        const int k2 = kt + half + 2 < NT ? kt + half + 2 : NT - 1;
        ar0 = *reinterpret_cast<const u32x4*>(abase + (size_t)k2 * 128 + aoff0); ar1 = *reinterpret_cast<const u32x4*>(abase + (size_t)k2 * 128 + aoff1);
        __syncthreads();
      }
    }
  }
}

__device__ __forceinline__ unsigned pack_pair(float v0, float v1, int odd) {
  const float send = odd ? v0 : v1;
  const float recv = __shfl_xor(send, 1);
  const float lo = odd ? recv : v0, hh = odd ? v1 : recv;
  return cvtpk(lo, hh);
}

__device__ __forceinline__ void cvt_range(const float* __restrict__ src, bf16_t* __restrict__ dst, size_t n8, size_t gtid, size_t gsz) {
  for (size_t i = gtid; i < n8; i += gsz) {
    const f32x4 a = *reinterpret_cast<const f32x4*>(src + i * 8), b = *reinterpret_cast<const f32x4*>(src + i * 8 + 4);
    *reinterpret_cast<bf16x8*>(dst + i * 8) = cvt8(a, b);
  }
}
__device__ __forceinline__ void pretile_dense(const float* __restrict__ src, int ld, int Nvalid, bf16_t* __restrict__ dst, int K, int N) {
  const int tid_o = opaque_tid(), lane = tid_o & 63, wv = blockIdx.x * 8 + (tid_o >> 6), nwv = gridDim.x * 8;
  const int nfr = (K / 16) * (N / 32);
  for (int f = wv; f < nfr; f += nwv) {
    const int ks = f / (N / 32), nb = f % (N / 32);
    const int n = nb * 32 + (lane & 31), k0 = ks * 16 + (lane >> 5) * 8;
    float v[8];
#pragma unroll
    for (int jj = 0; jj < 8; ++jj) v[jj] = n < Nvalid ? src[(size_t)(k0 + jj) * ld + n] : 0.f;
    u32x4 o = {cvtpk(v[0], v[1]), cvtpk(v[2], v[3]), cvtpk(v[4], v[5]), cvtpk(v[6], v[7])};
    *reinterpret_cast<u32x4*>((char*)dst + (size_t)f * 1024 + lane * 16) = o;
  }
}
__device__ __forceinline__ void phase_prologue(const Params& p, char* lds) {
  const size_t gtid = (size_t)blockIdx.x * NTHR + threadIdx.x, gsz = (size_t)gridDim.x * NTHR;
  char* ws = p.ws;
  auto small_jobs = [&]() {
  if (blockIdx.x == 0) { ((int*)(ws + OFF_CNTP))[threadIdx.x * CNT_STRIDE] = 0; }
  cvt_range(p.pool_w, (bf16_t*)(ws + OFF_WPOOL), 4 * 256 * 256 / 8, gtid, gsz);
  cvt_range(p.router_w, (bf16_t*)(ws + OFF_WR), 2 * DM * NEXP / 8, gtid, gsz);
  pretile_dense(p.w_uq, 1536, 1536, (bf16_t*)(ws + OFF_WUQ), QL, 1536);
  pretile_dense(p.w_uk, 1024, 1024, (bf16_t*)(ws + OFF_WUK), KVL, 1024);
  pretile_dense(p.w_uv, 1024, 1024, (bf16_t*)(ws + OFF_WUV), KVL, 1024);
  pretile_dense(p.w_o, DM, DM, (bf16_t*)(ws + OFF_WO), DM, DM);
  {
    bf16_t* wa = (bf16_t*)(ws + OFF_WA);
    for (size_t i = gtid; i < (size_t)DM * WA_NP / 8; i += gsz) {
      const int k = (int)(i / (WA_NP / 8)), n = (int)(i % (WA_NP / 8)) * 8;
      bf16x8 v = {0, 0, 0, 0, 0, 0, 0, 0};
      if (n < WA_N) { const float* s = p.w_a + (size_t)k * WA_N + n; v = cvt8(*reinterpret_cast<const f32x4*>(s), *reinterpret_cast<const f32x4*>(s + 4)); }
      *reinterpret_cast<bf16x8*>(wa + (size_t)k * WA_NP + n) = v;
    }
  }
  {
    float* rc = (float*)(ws + OFF_ROPE); float* rs = rc + SEQ * 32;
    for (size_t i = gtid; i < (size_t)SEQ * 32; i += gsz) {
      const int pos = (int)(i >> 5), j = (int)(i & 31);
      const double inv = exp(-(double)(2 * j) / 64.0 * 9.210340371976184);
      const double ang = (double)pos * inv;
      rc[i] = (float)cos(ang); rs[i] = (float)sin(ang);
    }
  }
  };
  {
    bf16_t* pooled = (bf16_t*)(ws + OFF_POOLED);
    float* tile = reinterpret_cast<float*>(lds);
    const int tid = threadIdx.x, cq = tid & 127, rg = tid >> 7;
    const int nit = ((NTOK / 32 - (int)blockIdx.x + (int)gridDim.x - 1) / (int)gridDim.x) * 2;
    f32x4 pre[12];
    auto fetch = [&](int it) {
      const int ch = blockIdx.x + (it >> 1) * gridDim.x, hf = it & 1, t0 = ch * 32, s0 = t0 & (SEQ - 1);
      const float* xb = p.x + (size_t)(t0 - s0) * DM;
#pragma unroll
      for (int i = 0; i < 12; ++i) {
        const int q = i * 512 + tid, rl = q >> 7, c4 = (q & 127) * 4, r = s0 - 8 + rl;
        if (r >= 0 && r < SEQ) pre[i] = *reinterpret_cast<const f32x4*>(xb + (size_t)r * DM + hf * 512 + c4);
      }
    };
    if (nit > 0) fetch(0);
    small_jobs();
    for (int it = 0; it < nit; ++it) {
      const int ch = blockIdx.x + (it >> 1) * gridDim.x, hf = it & 1, t0 = ch * 32, s0 = t0 & (SEQ - 1);
      {
        __syncthreads();
#pragma unroll
        for (int i = 0; i < 12; ++i) {
          const int q = i * 512 + tid, rl = q >> 7, c4 = (q & 127) * 4, r = s0 - 8 + rl;
          if (r >= 0 && r < SEQ) *reinterpret_cast<f32x4*>(tile + rl * 512 + c4) = pre[i];
        }
        __syncthreads();
        if (it + 1 < nit) fetch(it + 1);
        const int c = cq * 4, g = (hf * 512 + c) >> 8, hw = 1 << g;
#pragma unroll 1
        for (int rr = 0; rr < 8; ++rr) {
          const int t = s0 + rg * 8 + rr;
          const int lo = t - hw < 0 ? 0 : t - hw, hi = t + hw > SEQ ? SEQ : t + hw;
          f32x4 sum = {0.f, 0.f, 0.f, 0.f};
          for (int r = lo; r < hi; ++r) sum += *reinterpret_cast<const f32x4*>(tile + (r - s0 + 8) * 512 + c);
          const f32x4 xv = *reinterpret_cast<const f32x4*>(tile + (t - s0 + 8) * 512 + c);
          const float inv = 1.f / (float)(hi - lo);
          u32x2 w = {cvtpk(sum[0] * inv - xv[0], sum[1] * inv - xv[1]), cvtpk(sum[2] * inv - xv[2], sum[3] * inv - xv[3])};
          *reinterpret_cast<u32x2*>(pooled + (size_t)(t0 + rg * 8 + rr) * DM + hf * 512 + c) = w;
        }
      }
    }
    __syncthreads();
  }
}

constexpr int GBN = 256, GBK = 64;
enum { EPI_POOL = 0, EPI_F32 = 1, EPI_Q = 2, EPI_K = 3, EPI_V = 4, EPI_WO = 5 };


__device__ __forceinline__ void acc_bf16x8(f32x4& lo, f32x4& hi4, u32x4 w) {
  lo[0] += __uint_as_float(w[0] << 16); lo[1] += __uint_as_float(w[0] & 0xffff0000u); lo[2] += __uint_as_float(w[1] << 16); lo[3] += __uint_as_float(w[1] & 0xffff0000u);
  hi4[0] += __uint_as_float(w[2] << 16); hi4[1] += __uint_as_float(w[2] & 0xffff0000u); hi4[2] += __uint_as_float(w[3] << 16); hi4[3] += __uint_as_float(w[3] & 0xffff0000u);
}
constexpr int EPW = 68;
constexpr int EP_WAVE_BYTES = 32 * EPW * 4;
__device__ __forceinline__ void epi_to_lds(const f32x16& a0, const f32x16& a1, float* w, int r32, int hi) {
#pragma unroll
  for (int r = 0; r < 16; ++r) { w[crow(r, hi) * EPW + r32] = a0[r]; w[crow(r, hi) * EPW + 32 + r32] = a1[r]; }
}
template <int EPI>
__device__ __forceinline__ void dense_epilogue(const Params& p, char* lds, f32x16& a0, f32x16& a1, int mb, int nb, float* outf, bf16_t* outb, int ldo, int aux) {
  const int tid = opaque_tid(), lane = tid & 63, wid = tid >> 6, r32 = lane & 31, hi = lane >> 5;
  float* w = reinterpret_cast<float*>(lds + wid * EP_WAVE_BYTES);
  if constexpr (EPI == EPI_Q) {
    if (((nb >> 6) % 3) == 2) {
      const float* rc = (const float*)(p.ws + OFF_ROPE); const float* rs = rc + SEQ * 32;
#pragma unroll
      for (int r = 0; r < 16; ++r) {
        const int pos = (mb + crow(r, hi)) & (SEQ - 1);
        const float c = rc[pos * 32 + r32], sn = rs[pos * 32 + r32];
        const float x1 = a0[r], x2 = a1[r];
        a0[r] = x1 * c - x2 * sn; a1[r] = x1 * sn + x2 * c;
      }
    }
  }
  epi_to_lds(a0, a1, w, r32, hi);
  if constexpr (EPI == EPI_POOL || EPI == EPI_WO) {
#pragma unroll
    for (int it = 0; it < 4; ++it) {
      const int idx = it * 64 + lane, row = idx >> 3, c8 = (idx & 7) * 8;
      f32x4 v0 = *reinterpret_cast<const f32x4*>(w + row * EPW + c8), v1 = *reinterpret_cast<const f32x4*>(w + row * EPW + c8 + 4);
      size_t o;
      if constexpr (EPI == EPI_POOL) {
        const int n = aux * 256 + nb + c8; o = (size_t)(mb + row) * DM + n;
        v0 = (v0 + *reinterpret_cast<const f32x4*>(p.pool_b + n)) * *reinterpret_cast<const f32x4*>(p.pool_scale + n) + *reinterpret_cast<const f32x4*>(p.x + o) * ALPHA;
        v1 = (v1 + *reinterpret_cast<const f32x4*>(p.pool_b + n + 4)) * *reinterpret_cast<const f32x4*>(p.pool_scale + n + 4) + *reinterpret_cast<const f32x4*>(p.x + o + 4) * ALPHA;
      } else {
        o = (size_t)(mb + row) * DM + nb + c8;
        f32x4 h0 = {0.f, 0.f, 0.f, 0.f}, h1 = {0.f, 0.f, 0.f, 0.f};
        acc_bf16x8(h0, h1, *reinterpret_cast<const u32x4*>((const bf16_t*)(p.ws + OFF_H1B) + o));
        v0 += h0 * ALPHA; v1 += h1 * ALPHA;
      }
      *reinterpret_cast<bf16x8*>(outb + o) = cvt8(v0, v1);
    }
  } else if constexpr (EPI == EPI_F32) {
#pragma unroll
    for (int it = 0; it < 8; ++it) {
      const int idx = it * 64 + lane, row = idx >> 4, c4 = (idx & 15) * 4;
      f32x4 v = *reinterpret_cast<const f32x4*>(w + row * EPW + c4);
      *reinterpret_cast<f32x4*>(outf + (size_t)(mb + row) * ldo + nb + c4) = v;
    }
  } else {
    int colbase;
    if constexpr (EPI == EPI_K) colbase = (nb >> 7) * 192 + (nb & 127); else colbase = nb;
#pragma unroll
    for (int it = 0; it < 4; ++it) {
      const int idx = it * 64 + lane, row = idx >> 3, c8 = (idx & 7) * 8;
      const f32x4 v0 = *reinterpret_cast<const f32x4*>(w + row * EPW + c8), v1 = *reinterpret_cast<const f32x4*>(w + row * EPW + c8 + 4);
      *reinterpret_cast<bf16x8*>(outb + (size_t)(mb + row) * ldo + colbase + c8) = cvt8(v0, v1);
    }
  }
}
template <int EPI>
__device__ __forceinline__ void dense_tile(const Params& p, char* lds, const bf16_t* A, int lda, const bf16_t* B, int ldb, int K, int m0, int n0,
                                           float* outf, bf16_t* outb, int ldo, int aux) {
  using C = GC<GBN, GBK>;
  int tid = opaque_tid(), lane = tid & 63, wid = tid >> 6, r32 = lane & 31, hi = lane >> 5, wm = wid >> 2, wn = wid & 3;
  f32x16 acc[2][2];
#pragma unroll
  for (int i = 0; i < 2; ++i)
#pragma unroll
    for (int j = 0; j < 2; ++j) acc[i][j] = f32x16{};
  const char* abase = (const char*)(A + (size_t)m0 * lda);
  const unsigned aoff0 = (unsigned)(((tid >> 3) * lda + (tid & 7) * 8) * 2), aoff1 = aoff0 + (unsigned)(64 * lda * 2);
  const int bk0 = tid / C::CPR, bc = (tid % C::CPR) * 8;
  __syncthreads();
  gemm_core<GBN, GBK, false, false, false, bf16_t>(acc, abase, aoff0, aoff1, (const char*)(B + n0), (unsigned)((bk0 * ldb + bc) * 2), (unsigned)(ldb * 2), bk0, bc, K / GBK, lds, nullptr);
  tid = opaque_tid(); lane = tid & 63; wid = tid >> 6; r32 = lane & 31; hi = lane >> 5; wm = wid >> 2; wn = wid & 3;
  const int nb = n0 + wn * 64;
#pragma unroll
  for (int i = 0; i < 2; ++i) dense_epilogue<EPI>(p, lds, acc[i][0], acc[i][1], m0 + wm * 64 + i * 32, nb, outf, outb, ldo, aux);
}

template <int EPI>
__device__ __forceinline__ void dense_tile512(const Params& p, char* lds, const bf16_t* A, int lda, const bf16_t* Bt, int Ncols, int K, int m0, int n0,
                                           float* outf, bf16_t* outb, int ldo, int aux) {
  using C = GC<GBN, GBK>;
  int tid = opaque_tid(), lane = tid & 63, wid = tid >> 6, r32 = lane & 31, hi = lane >> 5, wm = wid >> 2, wn = wid & 3;
  f32x16 acc[4][2];
#pragma unroll
  for (int i = 0; i < 4; ++i)
#pragma unroll
    for (int j = 0; j < 2; ++j) acc[i][j] = f32x16{};
  const char* abase = (const char*)(A + (size_t)m0 * lda);
  const unsigned aoff0 = (unsigned)(((tid >> 3) * lda + (tid & 7) * 8) * 2), aoff1 = aoff0 + (unsigned)(64 * lda * 2);
  const int wu = __builtin_amdgcn_readfirstlane(wid);
  __syncthreads();
  gemm_rs<4, false, false>(acc, abase, aoff0, aoff1, (const char*)Bt + (size_t)((n0 >> 6) + wu) * 2048, (Ncols >> 6) * 2048, K / 64, lds, nullptr, 0);
  tid = opaque_tid(); lane = tid & 63; wid = tid >> 6; r32 = lane & 31; hi = lane >> 5; wm = wid >> 2; wn = wid & 3;
  const int nb = n0 + wid * 64;
#pragma unroll
  for (int i = 0; i < 4; ++i) dense_epilogue<EPI>(p, lds, acc[i][0], acc[i][1], m0 + i * 32, nb, outf, outb, ldo, aux);
}

__device__ __forceinline__ void phase_pool_gemm(const Params& p, char* lds) {
  const bf16_t* pooled = (const bf16_t*)(p.ws + OFF_POOLED); const bf16_t* wp = (const bf16_t*)(p.ws + OFF_WPOOL);
  bf16_t* z = (bf16_t*)(p.ws + OFF_Z);
  for (int u = blockIdx.x; u < 128 * 4; u += gridDim.x) {
    const int mt = u >> 2, g = u & 3;
    dense_tile<EPI_POOL>(p, lds, pooled + g * 256, DM, wp + (size_t)g * 65536, 256, 256, mt * 128, 0, nullptr, z, DM, g);
  }
}
__device__ __forceinline__ void phase_router_gemm(const Params& p, char* lds, int layer) {
  const bf16_t* hb = (const bf16_t*)(p.ws + (layer == 0 ? OFF_H0B : OFF_H0B));
  const bf16_t* wr = (const bf16_t*)(p.ws + OFF_WR) + (size_t)layer * DM * NEXP;
  float* lg = (float*)(p.ws + OFF_LOGIT);
  float* lg1 = (float*)(p.ws + OFF_H1F);
  for (int u = blockIdx.x; u < 256; u += gridDim.x) { const int mt = u >> 1, kh = u & 1;
    dense_tile<EPI_F32>(p, lds, hb + kh * (DM / 2), DM, wr + (size_t)kh * (DM / 2) * NEXP, NEXP, DM / 2, mt * 128, 0, kh ? lg1 : lg, nullptr, NEXP, 0); }
}
__device__ __forceinline__ void phase_wa_gemm(const Params& p, char* lds) {
  const bf16_t* hb = (const bf16_t*)(p.ws + OFF_H1B); const bf16_t* wa = (const bf16_t*)(p.ws + OFF_WA);
  float* ab = (float*)(p.ws + OFF_ABUF);
  for (int u = blockIdx.x; u < 128 * 3; u += gridDim.x) { const int mt = u / 3, nt = u % 3;
    dense_tile<EPI_F32>(p, lds, hb, DM, wa, WA_NP, DM, mt * 128, nt * 256, ab, nullptr, WA_NP, 0); }
}
__device__ __forceinline__ void phase_qkv_gemm(const Params& p, char* lds) {
  const bf16_t* ql = (const bf16_t*)(p.ws + OFF_QLAT); const bf16_t* kvl = (const bf16_t*)(p.ws + OFF_KVLAT);
  const bf16_t* wuq = (const bf16_t*)(p.ws + OFF_WUQ); const bf16_t* wuk = (const bf16_t*)(p.ws + OFF_WUK); const bf16_t* wuv = (const bf16_t*)(p.ws + OFF_WUV);
  bf16_t* Q = (bf16_t*)(p.ws + OFF_Q); bf16_t* Kb = (bf16_t*)(p.ws + OFF_K); bf16_t* V = (bf16_t*)(p.ws + OFF_V);
  for (int u = blockIdx.x; u < 128 * 7; u += gridDim.x) {
    const int mt = u / 7, s = u % 7;
    if (s < 3) dense_tile512<EPI_Q>(p, lds, ql, QL, wuq, 1536, QL, mt * 128, s * 512, nullptr, Q, 1536, 0);
    else if (s < 5) dense_tile512<EPI_K>(p, lds, kvl, KVL, wuk, 1024, KVL, mt * 128, (s - 3) * 512, nullptr, Kb, 1536, 0);
    else dense_tile512<EPI_V>(p, lds, kvl, KVL, wuv, 1024, KVL, mt * 128, (s - 5) * 512, nullptr, V, 1024, 0);
  }
}
__device__ __forceinline__ void phase_wo_gemm(const Params& p, char* lds) {
  const bf16_t* O = (const bf16_t*)(p.ws + OFF_O); const bf16_t* wo = (const bf16_t*)(p.ws + OFF_WO);
  bf16_t* z = (bf16_t*)(p.ws + OFF_Z);
  for (int u = blockIdx.x; u < 128 * 2; u += gridDim.x) { const int mt = u >> 1, nt = u & 1;
    dense_tile512<EPI_WO>(p, lds, O, DM, wo, DM, DM, mt * 128, nt * 512, nullptr, z, DM, 0); }
}

__device__ __forceinline__ int lcol(int lane, int i) { return 512 * (i >> 1) + 8 * lane + 4 * (i & 1); }
__device__ __forceinline__ void ln_row_store(f32x4 (&v)[4], const float* g, const float* b, float* of, bf16_t* ob, int lane) {
  float s = 0.f;
#pragma unroll
  for (int i = 0; i < 4; ++i) s += v[i][0] + v[i][1] + v[i][2] + v[i][3];
  const float mu = wave_sum(s) * (1.f / DM);
  float q = 0.f;
#pragma unroll
  for (int i = 0; i < 4; ++i) { v[i] -= mu; q += v[i][0] * v[i][0] + v[i][1] * v[i][1] + v[i][2] * v[i][2] + v[i][3] * v[i][3]; }
  const float rstd = rsqrtf(wave_sum(q) * (1.f / DM) + LN_EPS);
#pragma unroll
  for (int i = 0; i < 4; ++i) {
    const int c = lcol(lane, i);
    const f32x4 gg = *reinterpret_cast<const f32x4*>(g + c), bb = *reinterpret_cast<const f32x4*>(b + c);
    v[i] = v[i] * rstd * gg + bb;
    if (of) *reinterpret_cast<f32x4*>(of + c) = v[i];
  }
  if (ob) {
    *reinterpret_cast<bf16x8*>(ob + lcol(lane, 0)) = cvt8(v[0], v[1]);
    *reinterpret_cast<bf16x8*>(ob + lcol(lane, 2)) = cvt8(v[2], v[3]);
  }
}
__device__ __forceinline__ void phase_ln(const Params& p, const float* g, const float* b, float* of, bf16_t* ob) {
  const bf16_t* z = (const bf16_t*)(p.ws + OFF_Z);
  const int tid_o = opaque_tid(), lane = tid_o & 63, wv = blockIdx.x * 8 + (tid_o >> 6);
  for (int t = wv; t < NTOK; t += gridDim.x * 8) {
    f32x4 v[4];
#pragma unroll
    for (int i = 0; i < 4; ++i) v[i] = f32x4{0.f, 0.f, 0.f, 0.f};
#pragma unroll
    for (int ch = 0; ch < 2; ++ch) acc_bf16x8(v[2 * ch], v[2 * ch + 1], *reinterpret_cast<const u32x4*>(z + (size_t)t * DM + lcol(lane, 2 * ch)));
    ln_row_store(v, g, b, of ? of + (size_t)t * DM : nullptr, ob ? ob + (size_t)t * DM : nullptr, lane);
  }
}
__device__ __forceinline__ void phase_combine_ln(const Params& p, const bf16_t* hres, const float* g, const float* b, float* of, bf16_t* ob) {
  const bf16_t* Y = (const bf16_t*)(p.ws + OFF_Y); const bf16_t* Ysh = (const bf16_t*)(p.ws + OFF_YSH);
  const int tid_o = opaque_tid(), lane = tid_o & 63, wv = blockIdx.x * 8 + (tid_o >> 6);
  for (int t = wv; t < NTOK; t += gridDim.x * 8) {
    f32x4 v[4];
#pragma unroll
    for (int i = 0; i < 4; ++i) v[i] = f32x4{0.f, 0.f, 0.f, 0.f};
#pragma unroll
    for (int ch = 0; ch < 2; ++ch) {
      const int c = lcol(lane, 2 * ch);
      acc_bf16x8(v[2 * ch], v[2 * ch + 1], *reinterpret_cast<const u32x4*>(hres + (size_t)t * DM + c));
      v[2 * ch] *= ALPHA; v[2 * ch + 1] *= ALPHA;
      acc_bf16x8(v[2 * ch], v[2 * ch + 1], __builtin_nontemporal_load(reinterpret_cast<const u32x4*>(Ysh + (size_t)t * DM + c)));
#pragma unroll
      for (int k = 0; k < TOPK; ++k) acc_bf16x8(v[2 * ch], v[2 * ch + 1], __builtin_nontemporal_load(reinterpret_cast<const u32x4*>(Y + ((size_t)t * TOPK + k) * DM + c)));
    }
    ln_row_store(v, g, b, of ? of + (size_t)t * DM : nullptr, ob ? ob + (size_t)t * DM : nullptr, lane);
  }
}

__device__ __forceinline__ void phase_route(const Params& p, char* lds, int layer) {
  const float* lg = (const float*)(p.ws + OFF_LOGIT); const float* lg1 = (const float*)(p.ws + OFF_H1F);
  const float* rb = p.router_b + layer * NEXP;
  int* cnt = (int*)(p.ws + OFF_CNTP) + layer * NEXP * CNT_STRIDE;
  int* list = (int*)(p.ws + OFF_LIST);
  float* gate = (float*)(p.ws + OFF_GATE);
  int* texp = (int*)(p.ws + OFF_TEXP);
  int* hist = (int*)lds; int* base = hist + NEXP; int* s_e = base + NEXP; int* s_pos = s_e + 512; float* s_g = (float*)(s_pos + 512);
  float* glist = (float*)(p.ws + OFF_GLIST);
  const int tid = threadIdx.x, lane = tid & 63, wid = tid >> 6;
  const f32x4 bias = *reinterpret_cast<const f32x4*>(rb + lane * 4);
  const int per = (NTOK + (int)gridDim.x - 1) / (int)gridDim.x;
  const int tb0 = blockIdx.x * per, tb1 = tb0 + per < NTOK ? tb0 + per : NTOK;
  for (int c0 = tb0; c0 < tb1; c0 += 64) {
    __syncthreads();
    if (tid < NEXP) hist[tid] = 0;
    __syncthreads();
    f32x4 zz[8];
#pragma unroll
    for (int j = 0; j < 8; ++j) { const int t = c0 + wid * 8 + j; const size_t o = (size_t)(t < tb1 ? t : tb1 - 1) * NEXP + lane * 4; zz[j] = *reinterpret_cast<const f32x4*>(lg + o) + *reinterpret_cast<const f32x4*>(lg1 + o); }
#pragma unroll
    for (int jp = 0; jp < 4; ++jp) {
      float sc[2][4], bv[2][4];
      int tl[2], tt[2]; bool ok[2];
#pragma unroll
      for (int u = 0; u < 2; ++u) {
        tl[u] = wid * 8 + 2 * jp + u; tt[u] = c0 + tl[u]; ok[u] = tt[u] < tb1;
        const f32x4 z = zz[2 * jp + u];
#pragma unroll
        for (int k = 0; k < 4; ++k) { sc[u][k] = 1.f / (1.f + __expf(-z[k])); bv[u][k] = sc[u][k] + bias[k]; }
      }
      const int grp = lane >> 3;
#pragma unroll
      for (int u = 0; u < 2; ++u) {
        float m1 = fmaxf(bv[u][0], bv[u][1]), m2 = fminf(bv[u][0], bv[u][1]);
#pragma unroll
        for (int k = 2; k < 4; ++k) { const float a = bv[u][k]; const float n1 = fmaxf(m1, a); m2 = fmaxf(fminf(m1, a), m2); m1 = n1; }
#define TOP2_STEP(CTRL) { const float o1 = dppf<CTRL>(m1), o2 = dppf<CTRL>(m2); const float n1 = fmaxf(m1, o1); m2 = fmaxf(fminf(m1, o1), fmaxf(m2, o2)); m1 = n1; }
        TOP2_STEP(DPP_XOR1) TOP2_STEP(DPP_XOR2) TOP2_STEP(DPP_HALF_MIRROR)
#undef TOP2_STEP
        const float gs = m1 + m2;
        int rank = 0;
#pragma unroll
        for (int g2 = 0; g2 < 8; ++g2) { const float og = rdlane(gs, g2 * 8); rank += (og > gs || (og == gs && g2 < grp)) ? 1 : 0; }
        const bool sel = rank < 4;
#pragma unroll
        for (int k = 0; k < 4; ++k) if (!sel) bv[u][k] = -INFINITY;
      }
      int my_e[2] = {0, 0}; float my_s[2] = {0.f, 0.f}, ssum[2] = {0.f, 0.f};
#pragma unroll 1
      for (int kk = 0; kk < TOPK; ++kk) {
#pragma unroll
        for (int u = 0; u < 2; ++u) {
          float lb = bv[u][0]; int li = 0;
#pragma unroll
          for (int k = 1; k < 4; ++k) if (bv[u][k] > lb) { lb = bv[u][k]; li = k; }
          const float mx = wave_max(lb);
          const unsigned long long bal = __ballot(lb == mx);
          const int wl = __builtin_amdgcn_readfirstlane(__ffsll((long long)bal) - 1);
          const int we = __builtin_amdgcn_readlane(lane * 4 + li, wl);
          float ws_ = sc[u][0];
#pragma unroll
          for (int k = 1; k < 4; ++k) if (li == k) ws_ = sc[u][k];
          ws_ = rdlane(ws_, wl);
#pragma unroll
          for (int k = 0; k < 4; ++k) if (lane == wl && li == k) bv[u][k] = -INFINITY;
          ssum[u] += ws_;
          if (lane == kk) { my_e[u] = we; my_s[u] = ws_; }
        }
      }
#pragma unroll
      for (int u = 0; u < 2; ++u) {
        if (ok[u] && lane < TOPK) {
          s_e[tl[u] * 8 + lane] = my_e[u];
          s_pos[tl[u] * 8 + lane] = atomicAdd(&hist[my_e[u]], 1);
          const float gv = my_s[u] / ssum[u] * 2.5f;
          gate[tt[u] * TOPK + lane] = gv; s_g[tl[u] * 8 + lane] = gv;
          texp[tt[u] * TOPK + lane] = my_e[u];
        }
      }
    }
    __syncthreads();
    if (tid < NEXP) { const int h = hist[tid]; base[tid] = h ? atomicAdd(&cnt[tid * CNT_STRIDE], h) : 0; }
    __syncthreads();
    {
      const int tl = tid >> 3, t = c0 + tl;
      if (t < tb1) { const int e = s_e[tid]; const size_t li = (size_t)e * NTOK + base[e] + s_pos[tid]; list[li] = t * TOPK + (tid & 7); glist[li] = s_g[tid]; }
    }
  }
}

__device__ __forceinline__ void phase_mla_rows(const Params& p) {
  const float* ab = (const float*)(p.ws + OFF_ABUF);
  bf16_t* ql = (bf16_t*)(p.ws + OFF_QLAT); bf16_t* kvl = (bf16_t*)(p.ws + OFF_KVLAT); bf16_t* Kb = (bf16_t*)(p.ws + OFF_K);
  const float* rc = (const float*)(p.ws + OFF_ROPE); const float* rs = rc + SEQ * 32;
  const int tid_o = opaque_tid(), lane = tid_o & 63, wv = blockIdx.x * 8 + (tid_o >> 6);
  for (int t = wv; t < NTOK; t += gridDim.x * 8) {
    const float* a = ab + (size_t)t * WA_NP;
    float q[6], kv[4];
    float sq = 0.f, sk = 0.f;
#pragma unroll
    for (int i = 0; i < 6; ++i) { q[i] = a[lane + 64 * i]; sq += q[i] * q[i]; }
#pragma unroll
    for (int i = 0; i < 4; ++i) { kv[i] = a[QL + lane + 64 * i]; sk += kv[i] * kv[i]; }
    const float rq = rsqrtf(wave_sum(sq) * (1.f / QL) + RMS_EPS), rk = rsqrtf(wave_sum(sk) * (1.f / KVL) + RMS_EPS);
#pragma unroll
    for (int i = 0; i < 6; ++i) ql[(size_t)t * QL + lane + 64 * i] = f2bf(q[i] * rq * p.qn_g[lane + 64 * i]);
#pragma unroll
    for (int i = 0; i < 4; ++i) kvl[(size_t)t * KVL + lane + 64 * i] = f2bf(kv[i] * rk * p.kvn_g[lane + 64 * i]);
    const float mine = a[QL + KVL + lane];
    const float other = __shfl_xor(mine, 32);
    const int pos = t & (SEQ - 1), j = lane & 31;
    const float c = rc[pos * 32 + j], s = rs[pos * 32 + j];
    const float o = lane < 32 ? mine * c - other * s : other * s + mine * c;
    const bf16_t ob = f2bf(o);
#pragma unroll
    for (int h = 0; h < NH; ++h) Kb[(size_t)t * 1536 + h * DQK + DNOPE + lane] = ob;
  }
}

#ifndef MOE_PF
#define MOE_PF 3
#endif
#ifndef MOE_STAGGER
#define MOE_STAGGER 0
#endif
#ifndef MOE_ROUND_SYNC
#define MOE_ROUND_SYNC 0
#endif
constexpr int MOE_STAGE = 2 * GC<512, 32>::STAGE;
constexpr int MOE_HB = MOE_STAGE;
constexpr int MOE_META = MOE_HB + 65536;
constexpr int LDS_BYTES = MOE_META + 128 * 4 + 128 * 4 + 260 * 4 + 1024;
static_assert(LDS_BYTES <= 160 * 1024, "LDS");

__device__ __forceinline__ void phase_moe(const Params& p, char* lds, int layer) {
  using C = GC<512, 32>;
  int tid = threadIdx.x, lane = tid & 63, wid = tid >> 6, r32 = lane & 31, hi = lane >> 5, wm = wid >> 2, wn = wid & 3;
  const int* cnt = (const int*)(p.ws + OFF_CNTP) + layer * NEXP * CNT_STRIDE;
  const int* list = (const int*)(p.ws + OFF_LIST);
  const float* glist = (const float*)(p.ws + OFF_GLIST);
  const bf16_t* hin = (const bf16_t*)(p.ws + (layer == 0 ? OFF_H0B : OFF_H0B));
  bf16_t* Y = (bf16_t*)(p.ws + OFF_Y); bf16_t* Ysh = (bf16_t*)(p.ws + OFF_YSH);
  int* s_slot = (int*)(lds + MOE_META); float* s_gate = (float*)(lds + MOE_META + 512); int* s_pre = (int*)(lds + MOE_META + 1024);
  int* const s_slot0 = s_slot; float* const s_gate0 = s_gate; int* const s_slot1 = (int*)(lds + MOE_META + 1024 + 260 * 4); float* const s_gate1 = (float*)(s_slot1 + 128);
  char* hb = lds + MOE_HB;
  if (tid < 64) {
    int run = 0;
    for (int c0 = 0; c0 < 256; c0 += 64) {
      const int e = c0 + tid; const int tl = (cnt[e * CNT_STRIDE] + 127) >> 7;
      int incl = tl;
#pragma unroll
      for (int o = 1; o < 64; o <<= 1) { const int v = __shfl_up(incl, o); if (lane >= o) incl += v; }
      s_pre[e] = run + incl - tl;
      run += __shfl(incl, 63);
    }
    if (tid == 0) { s_pre[256] = run; s_pre[257] = run + 128; }
  }
  __syncthreads();
  const int U = __builtin_amdgcn_readfirstlane(s_pre[257]);
  Deal dl = get_deal(p, lds + LDS_BYTES);
  dl.xg = __builtin_amdgcn_readfirstlane(dl.xg); dl.ngroups = __builtin_amdgcn_readfirstlane(dl.ngroups); dl.rk = __builtin_amdgcn_readfirstlane(dl.rk); dl.ng = __builtin_amdgcn_readfirstlane(dl.ng);
  const int ustart = (int)((long long)U * dl.xg / dl.ngroups), uend = (int)((long long)U * (dl.xg + 1) / dl.ngroups);
  const int nrounds = (uend - ustart + dl.ng - 1) / dl.ng;
  bool have = false; int c_e = 0, c_tile = 0, sb = 0;
  u32x4 pre[8];
  u32x4 pre_a;
  auto fetch_a0 = [&](const int* slots, bool sh) {
    const int t3 = opaque_tid();
    const int sl = slots[t3 >> 2];
    const int tok = sl < 0 ? 0 : (sh ? sl : (sl >> 3));
    pre_a = *reinterpret_cast<const u32x4*>((const char*)hin + (size_t)((unsigned)(tok * (DM * 2) + (t3 & 3) * 16)));
  };
  auto fetch_pre1 = [&](int e) {
    const int t3 = opaque_tid(), l3 = t3 & 63, w3 = t3 >> 6;
    const float* wsrc;
    if (e == 256) wsrc = ((w3 & 1) ? p.sw_up : p.sw_gate) + (size_t)layer * DM * EFF;
    else { const size_t eo = (size_t)layer * NEXP + (MOE_HACK == 1 ? 0 : (MOE_HACK == 10 ? (e & ~3) : e)); wsrc = ((w3 & 1) ? p.ew_up : p.ew_gate) + eo * DM * EFF; }
    const char* pb = (const char*)wsrc + (size_t)((unsigned)((((w3 >> 1) * 8) * EFF + l3 * 4) * 4));
#pragma unroll
    for (int i = 0; i < 8; ++i) pre[i] = *reinterpret_cast<const u32x4*>(pb + (size_t)i * (EFF * 4));
  };
  auto find_unit = [&](int u, int& e, int& tile) {
    int lo = 0, hi_ = 256;
    while (lo < hi_) { const int mid = (lo + hi_ + 1) >> 1; if (s_pre[mid] <= u) lo = mid; else hi_ = mid - 1; }
    e = __builtin_amdgcn_readfirstlane(lo); tile = __builtin_amdgcn_readfirstlane(u - s_pre[lo]);
  };
  auto fetch_slots = [&](int e, int tile, int& slot, float& gt) {
    const int t3 = opaque_tid();
    slot = -1; gt = 0.f;
    if (t3 < 128) {
      if (e == 256) { slot = tile * 128 + t3; gt = 1.f; }
      else { const int idx = tile * 128 + t3; if (idx < cnt[e * CNT_STRIDE]) { slot = list[(size_t)e * NTOK + idx]; gt = glist[(size_t)e * NTOK + idx]; } }
    }
  };
  for (int round = 0; round < nrounds; ++round) {
    const int u = ustart + dl.rk + round * dl.ng;
    if (u < uend) {
    int h_slot = -1; float h_gt = 0.f;
    const bool had = have;
    if (!had) { find_unit(u, c_e, c_tile); fetch_slots(c_e, c_tile, h_slot, h_gt); fetch_pre1(c_e); }
    const int e = c_e, tile = c_tile;
    const bool shared = e == 256;
    s_slot = sb ? s_slot1 : s_slot0; s_gate = sb ? s_gate1 : s_gate0;
#if MOE_HACK == 9
    if (!(!shared && tile > 0)) {
#else
    {
#endif
#if MOE_STAGGER
    if (!shared && tile > 0) {
      const unsigned long long t0 = __builtin_amdgcn_s_memrealtime();
      while (__builtin_amdgcn_s_memrealtime() - t0 < (unsigned long long)(MOE_STAGGER * tile)) __builtin_amdgcn_s_sleep(4);
    }
#endif
    __syncthreads();
    tid = opaque_tid(); lane = tid & 63; wid = tid >> 6; r32 = lane & 31; hi = lane >> 5; wm = wid >> 2; wn = wid & 3;
    if (!had && tid < 128) { s_slot[tid] = h_slot; s_gate[tid] = h_gt; }
    __syncthreads();
    if (!had) fetch_a0(s_slot, shared);
    const float *wg, *wu, *wd;
    if (shared) { wg = p.sw_gate + (size_t)layer * DM * EFF; wu = p.sw_up + (size_t)layer * DM * EFF; wd = p.sw_down + (size_t)layer * EFF * DM; }
    else { const size_t eo = (size_t)layer * NEXP + (MOE_HACK == 1 ? 0 : (MOE_HACK == 10 ? (e & ~3) : e)); wg = p.ew_gate + eo * DM * EFF; wu = p.ew_up + eo * DM * EFF; wd = p.ew_down + eo * EFF * DM; }
    f32x16 acc[2][4];
#pragma unroll
    for (int i = 0; i < 2; ++i)
#pragma unroll
      for (int j = 0; j < 4; ++j) acc[i][j] = f32x16{};
    {
      const int sl = s_slot[tid >> 2];
      const int tok = sl < 0 ? 0 : (shared ? sl : (sl >> 3));
      const unsigned aoff = (unsigned)(tok * (DM * 2) + (tid & 3) * 16);
      const int arr = __builtin_amdgcn_readfirstlane(wid) & 1, bk0 = (wid >> 1) * 8, cl = lane * 4;
      const char* bbase = (const char*)(arr ? wu : wg);
      gemm_core<512, 32, true, false, true, float, MOE_PF>(acc, (const char*)hin, aoff, aoff, bbase, (unsigned)((bk0 * EFF + cl) * 4), (unsigned)(EFF * 4), bk0, arr * 256 + cl, (MOE_HACK == 12 ? 8 : DM / 32), lds, nullptr, pre, &pre_a);
    }
    {
      const int t2 = opaque_tid(), l2 = t2 & 63, w2 = t2 >> 6;
      const char* pb = (const char*)wd + (size_t)((unsigned)((((w2 >> 1) * 8) * DM + (w2 & 1) * 256 + l2 * 4) * 4));
#pragma unroll
      for (int i = 0; i < 8; ++i) pre[i] = *reinterpret_cast<const u32x4*>(pb + (size_t)i * (DM * 4));
    }
    tid = opaque_tid(); lane = tid & 63; wid = tid >> 6; r32 = lane & 31; hi = lane >> 5; wm = wid >> 2; wn = wid & 3;
#pragma unroll
    for (int i = 0; i < 2; ++i) {
      const int m = wm * 64 + i * 32 + r32;
#pragma unroll
      for (int j = 0; j < 2; ++j) {
#pragma unroll
        for (int q = 0; q < 4; ++q) {
          float hv[4];
#pragma unroll
          for (int e2 = 0; e2 < 4; ++e2) { const float g = acc[i][j][4 * q + e2], uu = acc[i][j + 2][4 * q + e2]; hv[e2] = g * __builtin_amdgcn_rcpf(1.f + __expf(-g)) * uu; }
          const int chunk = 8 * wn + 4 * j + q;
          u32x2 w = {cvtpk(hv[0], hv[1]), cvtpk(hv[2], hv[3])};
          *reinterpret_cast<u32x2*>(hb + hb_off(m, chunk) + 8 * hi) = w;
        }
      }
    }
    __syncthreads();
    bf16_t* Yo = shared ? Ysh : Y;
#pragma unroll 1
    for (int pz = 0; pz < 2; ++pz) {
#pragma unroll
      for (int i = 0; i < 2; ++i)
#pragma unroll
        for (int j = 0; j < 4; ++j) acc[i][j] = f32x16{};
      {
        const int half = wid & 1, bk0 = (wid >> 1) * 8, cl = half * 256 + lane * 4;
        gemm_core<512, 32, false, true, false, float, MOE_PF>(acc, nullptr, 0u, 0u, (const char*)(wd + pz * 512), (unsigned)((bk0 * DM + cl) * 4), (unsigned)(DM * 4), bk0, cl, EFF / 32, lds, hb, pre);
        if (pz == 0) {
          const char* pb = (const char*)(wd + 512) + (size_t)((unsigned)((bk0 * DM + cl) * 4));
#pragma unroll
          for (int i = 0; i < 8; ++i) pre[i] = *reinterpret_cast<const u32x4*>(pb + (size_t)i * (DM * 4));
        }
      }
      int n_slot = -1; float n_gt = 0.f;
      if (pz == 0) {
        const int un = u + dl.ng;
        have = un < uend;
        if (have) { find_unit(un, c_e, c_tile); fetch_slots(c_e, c_tile, n_slot, n_gt); }
      } else if (have) {
        fetch_a0(sb ? s_slot0 : s_slot1, c_e == 256);
        fetch_pre1(c_e);
      } else {
        pre_a = u32x4{0u, 0u, 0u, 0u};
#pragma unroll
        for (int i = 0; i < 8; ++i) pre[i] = u32x4{0u, 0u, 0u, 0u};
      }
      tid = opaque_tid(); lane = tid & 63; wid = tid >> 6; r32 = lane & 31; hi = lane >> 5; wm = wid >> 2; wn = wid & 3;
      const int odd = lane & 1;
      {
        float* wpatch = reinterpret_cast<float*>(lds + wid * EP_WAVE_BYTES);
#pragma unroll
        for (int i = 0; i < 2; ++i) {
#pragma unroll
          for (int jp = 0; jp < 2; ++jp) {
            epi_to_lds(acc[i][2 * jp], acc[i][2 * jp + 1], wpatch, r32, hi);
#pragma unroll
            for (int it = 0; it < 4; ++it) {
              const int idx = it * 64 + lane, row = idx >> 3, c8 = (idx & 7) * 8;
              const int ml = wm * 64 + i * 32 + row;
              const float g = s_gate[ml]; const int slot = s_slot[ml];
              const f32x4 v0 = *reinterpret_cast<const f32x4*>(wpatch + row * EPW + c8) * g, v1 = *reinterpret_cast<const f32x4*>(wpatch + row * EPW + c8 + 4) * g;
              if (slot >= 0) __builtin_nontemporal_store(cvt8(v0, v1), reinterpret_cast<bf16x8*>(Yo + (size_t)slot * DM + pz * 512 + wn * 128 + jp * 64 + c8));
            }
          }
        }
      }
      if (pz == 0 && have && tid < 128) { int* ns = sb ? s_slot0 : s_slot1; float* ng = sb ? s_gate0 : s_gate1; ns[tid] = n_slot; ng[tid] = n_gt; }
      __syncthreads();
    }
    if (have) sb ^= 1;
    }
    }
    if (dl.census && MOE_ROUND_SYNC) round_barrier(p, lds + LDS_BYTES, layer, round, dl.ng);
  }
}

namespace at {
constexpr int KVBLK = 64;
constexpr int QREG = 8;
constexpr float SCALE = 0.07216878364870323f;
constexpr float THR = 8.f;
constexpr int LDQ = 1536, LDK = 1536, LDV = 1024, LDO = 1024;
constexpr int SHM_V = 16384, SHM_KN = 16384, SHM_KR = 8192;
constexpr int OFF_KN = 2 * SHM_V, OFF_KR = OFF_KN + 2 * SHM_KN, OFF_WS = OFF_KR + 2 * SHM_KR, OFF_QR = OFF_WS + 8 * 64 * 4;
#define KSWZ(row, colB) ((row) * 256 + ((colB) ^ (((row) & 7) << 4)))
#define KRSWZ(row, colB) ((row) * 128 + ((colB) ^ ((((row) >> 1) & 7) << 4)))

__device__ __forceinline__ void partialSM(f32x16& p0, f32x16& p1, float& m_reg, float& mn, float& alpha) {
  constexpr float C = SCALE * 1.4426950408889634f;
  float pmax = p0[0];
#pragma unroll
  for (int r = 1; r < 16; ++r) pmax = fmaxf(pmax, p0[r]);
#pragma unroll
  for (int r = 0; r < 16; ++r) pmax = fmaxf(pmax, p1[r]);
  { auto rr = __builtin_amdgcn_permlane32_swap(__float_as_uint(pmax), __float_as_uint(pmax), false, false);
    pmax = fmaxf(__uint_as_float(rr[0]), __uint_as_float(rr[1])); }
  if (__builtin_expect(__all(pmax - m_reg <= THR / SCALE), 1)) { mn = m_reg; alpha = 1.f; }
  else { mn = fmaxf(m_reg, pmax); alpha = __builtin_amdgcn_exp2f((m_reg - mn) * C); m_reg = mn; }
  const float mnC = -mn * C;
#pragma unroll
  for (int r = 0; r < 16; ++r) p0[r] = fmaf(p0[r], C, mnC);
#pragma unroll
  for (int r = 0; r < 16; ++r) p1[r] = fmaf(p1[r], C, mnC);
#pragma unroll
  for (int r = 0; r < 16; ++r) p0[r] = __builtin_amdgcn_exp2f(p0[r]);
}
__device__ __forceinline__ void finishSM(f32x16& p0, f32x16& p1, float alpha, float& l_reg, bf16x8& pa0, bf16x8& pa1, bf16x8& pa2, bf16x8& pa3) {
#pragma unroll
  for (int r = 0; r < 16; ++r) p1[r] = __builtin_amdgcn_exp2f(p1[r]);
  float ps = 0;
#pragma unroll
  for (int r = 0; r < 16; ++r) ps += p0[r];
#pragma unroll
  for (int r = 0; r < 16; ++r) ps += p1[r];
  { auto rr = __builtin_amdgcn_permlane32_swap(__float_as_uint(ps), __float_as_uint(ps), false, false);
    ps = __uint_as_float(rr[0]) + __uint_as_float(rr[1]); }
  l_reg = l_reg * alpha + ps;
#define PK4(P, BASE, OUT) do { unsigned a0 = cvtpk(P[BASE + 0], P[BASE + 1]), a1 = cvtpk(P[BASE + 2], P[BASE + 3]);   \
    unsigned b0 = cvtpk(P[BASE + 4], P[BASE + 5]), b1 = cvtpk(P[BASE + 6], P[BASE + 7]);                              \
    auto r0 = __builtin_amdgcn_permlane32_swap(a0, b0, false, false); auto r1 = __builtin_amdgcn_permlane32_swap(a1, b1, false, false); \
    u32x4 w = {r0[0], r1[0], r0[1], r1[1]}; OUT = *reinterpret_cast<bf16x8*>(&w); } while (0)
  PK4(p0, 0, pa0); PK4(p0, 8, pa1); PK4(p1, 0, pa2); PK4(p1, 8, pa3);
#undef PK4
}
__device__ __forceinline__ void qkt(f32x16& p0, f32x16& p1, const char* Kn, const char* Kr, const bf16x8* qr, const char* qrl, int r32, int hi) {
  p0 = f32x16{}; p1 = f32x16{};
#pragma unroll
  for (int d0 = 0; d0 < QREG; ++d0) { const int cb = (d0 * 16 + hi * 8) * 2;
    const bf16x8 b0 = *reinterpret_cast<const bf16x8*>(Kn + KSWZ(r32, cb));
    const bf16x8 b1 = *reinterpret_cast<const bf16x8*>(Kn + KSWZ(32 + r32, cb));
    p0 = __builtin_amdgcn_mfma_f32_32x32x16_bf16(b0, qr[d0], p0, 0, 0, 0);
    p1 = __builtin_amdgcn_mfma_f32_32x32x16_bf16(b1, qr[d0], p1, 0, 0, 0); }
#pragma unroll
  for (int d0 = QREG; d0 < 8; ++d0) { const int cb = (d0 * 16 + hi * 8) * 2;
    const bf16x8 b0 = *reinterpret_cast<const bf16x8*>(Kn + KSWZ(r32, cb));
    const bf16x8 b1 = *reinterpret_cast<const bf16x8*>(Kn + KSWZ(32 + r32, cb));
    const bf16x8 qv = *reinterpret_cast<const bf16x8*>(qrl + (d0 - QREG) * 8192);
    p0 = __builtin_amdgcn_mfma_f32_32x32x16_bf16(b0, qv, p0, 0, 0, 0);
    p1 = __builtin_amdgcn_mfma_f32_32x32x16_bf16(b1, qv, p1, 0, 0, 0); }
#pragma unroll
  for (int d0 = 0; d0 < 4; ++d0) { const int cb = (d0 * 16 + hi * 8) * 2;
    const bf16x8 b0 = *reinterpret_cast<const bf16x8*>(Kr + KRSWZ(r32, cb));
    const bf16x8 b1 = *reinterpret_cast<const bf16x8*>(Kr + KRSWZ(32 + r32, cb));
    const bf16x8 qv = *reinterpret_cast<const bf16x8*>(qrl + (8 - QREG + d0) * 8192);
    p0 = __builtin_amdgcn_mfma_f32_32x32x16_bf16(b0, qv, p0, 0, 0, 0);
    p1 = __builtin_amdgcn_mfma_f32_32x32x16_bf16(b1, qv, p1, 0, 0, 0); }
}
__device__ __forceinline__ int v_st(int k, int c) { const int kk = (k & ~0xC) | ((k & 4) << 1) | ((k & 8) >> 1); return ((kk >> 3) * 4 + (c >> 5)) * 512 + ((kk & 7) * 32 + (c & 31)) * 2; }
constexpr int v_rd_off(int d0, int ks, int half) { return d0 * 512 + ks * 4096 + half * 2048; }
template <int D0> __device__ __forceinline__ void pv_one(f32x16& od, int vb, bf16x8 pa0, bf16x8 pa1, bf16x8 pa2, bf16x8 pa3) {
  const s16x4 l0 = tr_read<v_rd_off(D0, 0, 0)>(vb), h0 = tr_read<v_rd_off(D0, 0, 1)>(vb), l1 = tr_read<v_rd_off(D0, 1, 0)>(vb), h1 = tr_read<v_rd_off(D0, 1, 1)>(vb);
  const s16x4 l2 = tr_read<v_rd_off(D0, 2, 0)>(vb), h2 = tr_read<v_rd_off(D0, 2, 1)>(vb), l3 = tr_read<v_rd_off(D0, 3, 0)>(vb), h3 = tr_read<v_rd_off(D0, 3, 1)>(vb);
  asm volatile("s_waitcnt lgkmcnt(0)" ::: "memory"); SBAR();
  od = __builtin_amdgcn_mfma_f32_32x32x16_bf16(pa0, PKF(l0, h0), od, 0, 0, 0);
  od = __builtin_amdgcn_mfma_f32_32x32x16_bf16(pa1, PKF(l1, h1), od, 0, 0, 0);
  od = __builtin_amdgcn_mfma_f32_32x32x16_bf16(pa2, PKF(l2, h2), od, 0, 0, 0);
  od = __builtin_amdgcn_mfma_f32_32x32x16_bf16(pa3, PKF(l3, h3), od, 0, 0, 0);
}
__device__ __forceinline__ void pv_d0(f32x16* o, int vb, bf16x8 pa0, bf16x8 pa1, bf16x8 pa2, bf16x8 pa3) {
  pv_one<0>(o[0], vb, pa0, pa1, pa2, pa3); pv_one<1>(o[1], vb, pa0, pa1, pa2, pa3); pv_one<2>(o[2], vb, pa0, pa1, pa2, pa3); pv_one<3>(o[3], vb, pa0, pa1, pa2, pa3);
}

__device__ __forceinline__ void attn_body(const bf16_t* __restrict__ Qb, const bf16_t* __restrict__ Kh, const bf16_t* __restrict__ Vh,
                                          bf16_t* __restrict__ Ob, int seq, char* lds) {
  const int tid = opaque_tid(), wid = tid >> 6, lane = tid & 63, r32 = lane & 31, hi = lane >> 5;
  char* V_lds = lds; char* KN_lds = lds + OFF_KN; char* KR_lds = lds + OFF_KR;
  float* ws = (float*)(lds + OFF_WS) + wid * 64; float* li_l = ws; float* al_l = ws + 32;
  float m_reg = -1e30f, l_reg = 0; f32x16 o[4] = {}; bf16x8 qr[QREG];
  char* qrl = lds + OFF_QR + tid * 16;
  {
    const char* Qc = (const char*)Qb; const unsigned qoff = (unsigned)(((wid * 32 + r32) * LDQ + hi * 8) * 2);
#pragma unroll
    for (int d0 = 0; d0 < QREG; ++d0) qr[d0] = *reinterpret_cast<const bf16x8*>(Qc + qoff + d0 * 32);
#pragma unroll
    for (int d0 = QREG; d0 < 12; ++d0) *reinterpret_cast<bf16x8*>(qrl + (d0 - QREG) * 8192) = *reinterpret_cast<const bf16x8*>(Qc + qoff + d0 * 32);
  }
  const int sr = tid >> 4, sc = (tid & 15) * 8, vst0 = v_st(sr, sc), vst1 = v_st(32 + sr, sc);
  const int krr = tid >> 3, krc = (tid & 7) * 8;
  const int vb0 = (int)(uintptr_t)V_lds + v_rd_base(lane);
  const unsigned voff0 = (unsigned)((sr * LDV + sc) * 2), voff1 = voff0 + 32 * LDV * 2;
  const unsigned koff0 = (unsigned)((sr * LDK + sc) * 2), koff1 = koff0 + 32 * LDK * 2, koffr = (unsigned)((krr * LDK + DNOPE + krc) * 2);
  const char* Vc = (const char*)Vh; const char* Kc = (const char*)Kh;
  bf16x8 s_vs0, s_vs1, s_ks0, s_ks1, s_kr;
#define SLOAD(k0) do { const char* vt = Vc + (size_t)(k0) * (LDV * 2); const char* kt_ = Kc + (size_t)(k0) * (LDK * 2);                    \
    s_vs0 = *reinterpret_cast<const bf16x8*>(vt + voff0); s_vs1 = *reinterpret_cast<const bf16x8*>(vt + voff1);                          \
    s_ks0 = *reinterpret_cast<const bf16x8*>(kt_ + koff0); s_ks1 = *reinterpret_cast<const bf16x8*>(kt_ + koff1);                        \
    s_kr = *reinterpret_cast<const bf16x8*>(kt_ + koffr); } while (0)
#define SWRITE(b) do { *(bf16x8*)(V_lds + (b) * SHM_V + vst0) = s_vs0; *(bf16x8*)(V_lds + (b) * SHM_V + vst1) = s_vs1; const int kc = sc * 2; \
    *(bf16x8*)(KN_lds + (b) * SHM_KN + KSWZ(sr, kc)) = s_ks0; *(bf16x8*)(KN_lds + (b) * SHM_KN + KSWZ(32 + sr, kc)) = s_ks1;   \
    *(bf16x8*)(KR_lds + (b) * SHM_KR + KRSWZ(krr, krc * 2)) = s_kr; } while (0)
#define SWAIT() asm volatile("s_waitcnt vmcnt(0)" ::: "memory")
#define RESC(a) do { if (__any((a) < 1.f)) { if (hi == 0) al_l[r32] = (a); asm volatile("s_waitcnt lgkmcnt(0)" ::: "memory"); \
    for (int d = 0; d < 4; ++d) for (int r = 0; r < 16; ++r) o[d][r] *= al_l[crow(r, hi)]; } } while (0)
  f32x16 pA0, pA1, pB0, pB1; float mnA, mnB, alA, alB; bf16x8 pa0, pa1, pa2, pa3; const int NT = seq / KVBLK;
  if (__builtin_amdgcn_readfirstlane(tid) >= 256) __builtin_amdgcn_s_setprio(1);
  SLOAD(0); SWAIT(); SWRITE(0); __syncthreads();
  qkt(pA0, pA1, KN_lds, KR_lds, qr, qrl, r32, hi); partialSM(pA0, pA1, m_reg, mnA, alA);
  SLOAD(KVBLK);
  SWAIT(); SWRITE(1); __syncthreads();
#pragma unroll 1
  for (int j = 1; j + 1 < NT; j += 2) {
    SBAR(); qkt(pB0, pB1, KN_lds + SHM_KN, KR_lds + SHM_KR, qr, qrl, r32, hi);
    finishSM(pA0, pA1, alA, l_reg, pa0, pa1, pa2, pa3); SBAR();
    SLOAD((j + 1) * KVBLK); SBAR();
    pv_d0(o, vb0, pa0, pa1, pa2, pa3); partialSM(pB0, pB1, m_reg, mnB, alB);
    __syncthreads(); SWAIT(); SWRITE(0);
    RESC(alB); __syncthreads();
    SBAR(); qkt(pA0, pA1, KN_lds, KR_lds, qr, qrl, r32, hi);
    finishSM(pB0, pB1, alB, l_reg, pa0, pa1, pa2, pa3); SBAR();
    SLOAD((j + 2) * KVBLK); SBAR();
    pv_d0(o, vb0 + SHM_V, pa0, pa1, pa2, pa3); partialSM(pA0, pA1, m_reg, mnA, alA);
    __syncthreads(); SWAIT(); SWRITE(1);
    RESC(alA); __syncthreads();
  }
  SBAR(); qkt(pB0, pB1, KN_lds + SHM_KN, KR_lds + SHM_KR, qr, qrl, r32, hi);
  finishSM(pA0, pA1, alA, l_reg, pa0, pa1, pa2, pa3); SBAR();
  pv_d0(o, vb0, pa0, pa1, pa2, pa3); partialSM(pB0, pB1, m_reg, mnB, alB);
  __syncthreads(); RESC(alB);
  finishSM(pB0, pB1, alB, l_reg, pa0, pa1, pa2, pa3); SBAR();
  pv_d0(o, vb0 + SHM_V, pa0, pa1, pa2, pa3);
  if (hi == 0) li_l[r32] = l_reg; asm volatile("s_waitcnt lgkmcnt(0)" ::: "memory");
  float rli[16];
#pragma unroll
  for (int r = 0; r < 16; ++r) rli[r] = __builtin_amdgcn_rcpf(li_l[crow(r, hi)]);
  char* Oc = (char*)Ob;
  const int tid2 = opaque_tid(), lane2 = tid2 & 63, odd = lane2 & 1, hi2 = lane2 >> 5;
#pragma unroll
  for (int r = 0; r < 16; r += 2) {
    const unsigned ooff = (unsigned)((((tid2 >> 6) * 32 + crow(r, hi2) + odd) * LDO + (lane2 & 30)) * 2);
#pragma unroll
    for (int d0 = 0; d0 < 4; ++d0) {
      const unsigned pk = pack_pair(o[d0][r] * rli[r], o[d0][r + 1] * rli[r + 1], odd);
      *reinterpret_cast<unsigned*>(Oc + ooff + d0 * 64) = pk;
    }
  }
  __builtin_amdgcn_s_setprio(0);
#undef SLOAD
#undef SWRITE
#undef SWAIT
#undef RESC
}
}

__device__ __forceinline__ void phase_attn(const Params& p, char* lds) {
  const bf16_t* Q = (const bf16_t*)(p.ws + OFF_Q); const bf16_t* Kb = (const bf16_t*)(p.ws + OFF_K); const bf16_t* V = (const bf16_t*)(p.ws + OFF_V);
  bf16_t* O = (bf16_t*)(p.ws + OFF_O);
  const Deal dl = get_deal(p, lds + LDS_BYTES);
  for (int pair = dl.xg; pair < 16; pair += dl.ngroups) {
    const int b = pair >> 3, h = pair & 7;
    const size_t t0 = (size_t)b * SEQ;
    for (int qb = dl.rk; qb < 32; qb += dl.ng) {
      __syncthreads();
      at::attn_body(Q + (t0 + qb * 256) * 1536 + h * DQK, Kb + t0 * 1536 + h * DQK, V + t0 * 1024 + h * DVH, O + (t0 + qb * 256) * 1024 + h * DVH, SEQ, lds);
    }
  }
}


#if PROBE_T
#ifndef BENCH_MODE
#define BENCH_MODE 2
#endif
__device__ __forceinline__ void phase_bench(const Params& p) {
  const int tid = threadIdx.x, lane = tid & 63, wid = tid >> 6;
  const char* base = (const char*)(p.ew_gate + (size_t)(blockIdx.x % NEXP) * DM * EFF) + (size_t)((wid * 8) * EFF + lane * 4) * 4;
  u32x4 acc = {0, 0, 0, 0};
#if BENCH_MODE == 1
#pragma unroll 1
  for (int kt = 0; kt < 48; ++kt) {
    u32x4 v[8];
#pragma unroll
    for (int i = 0; i < 8; ++i) v[i] = *reinterpret_cast<const u32x4*>(base + (size_t)kt * 65536 + i * 1024);
#pragma unroll
    for (int i = 0; i < 8; ++i) acc ^= v[i];
    __syncthreads();
  }
#else
  u32x4 v0[8], v1[8];
#pragma unroll
  for (int i = 0; i < 8; ++i) v0[i] = *reinterpret_cast<const u32x4*>(base + i * 1024);
#pragma unroll 1
  for (int kt = 0; kt < 48; kt += 2) {
#pragma unroll
    for (int i = 0; i < 8; ++i) v1[i] = *reinterpret_cast<const u32x4*>(base + (size_t)(kt + 1) * 65536 + i * 1024);
#pragma unroll
    for (int i = 0; i < 8; ++i) acc ^= v0[i];
    __syncthreads();
#pragma unroll
    for (int i = 0; i < 8; ++i) v0[i] = *reinterpret_cast<const u32x4*>(base + (size_t)((kt + 2) % 48) * 65536 + i * 1024);
#pragma unroll
    for (int i = 0; i < 8; ++i) acc ^= v1[i];
    __syncthreads();
  }
#pragma unroll
  for (int i = 0; i < 8; ++i) acc ^= v0[i];
#endif
  if (acc[0] == 0x12345678u && acc[1] == 0x9abcdefu) ((unsigned*)(p.ws + OFF_DBG))[tid & 31] = acc[2];
}
#endif

constexpr int NPHASE = 17;
template <int PH> __device__ __forceinline__ void run_phase(const Params& p, char* lds) {
  char* ws = p.ws;
  if constexpr (PH == 0) phase_prologue(p, lds);
  else if constexpr (PH == 1) phase_pool_gemm(p, lds);
  else if constexpr (PH == 2) phase_ln(p, p.ln_mix_g, p.ln_mix_b, nullptr, (bf16_t*)(ws + OFF_H0B));
  else if constexpr (PH == 3) phase_router_gemm(p, lds, 0);
  else if constexpr (PH == 4) phase_route(p, lds, 0);
#if PROBE_T && defined(BENCH_ON)
  else if constexpr (PH == 5) phase_bench(p);
#else
  else if constexpr (PH == 5) phase_moe(p, lds, 0);
#endif
  else if constexpr (PH == 6) phase_combine_ln(p, (const bf16_t*)(ws + OFF_H0B), p.ln_ffn_g, p.ln_ffn_b, nullptr, (bf16_t*)(ws + OFF_H1B));
  else if constexpr (PH == 7) phase_wa_gemm(p, lds);
  else if constexpr (PH == 8) phase_mla_rows(p);
  else if constexpr (PH == 9) phase_qkv_gemm(p, lds);
  else if constexpr (PH == 10) phase_attn(p, lds);
  else if constexpr (PH == 11) phase_wo_gemm(p, lds);
  else if constexpr (PH == 12) phase_ln(p, p.ln_mix_g + DM, p.ln_mix_b + DM, nullptr, (bf16_t*)(ws + OFF_H0B));
  else if constexpr (PH == 13) phase_router_gemm(p, lds, 1);
  else if constexpr (PH == 14) phase_route(p, lds, 1);
  else if constexpr (PH == 15) phase_moe(p, lds, 1);
  else if constexpr (PH == 16) phase_combine_ln(p, (const bf16_t*)(ws + OFF_H0B), p.ln_ffn_g + DM, p.ln_ffn_b + DM, p.out, nullptr);
}

template <int PH> __global__ void __launch_bounds__(NTHR, 2) k_phase(Params p) {
  extern __shared__ __attribute__((aligned(16))) char lds[];
  if (threadIdx.x == 0) *reinterpret_cast<uint4*>(lds + LDS_BYTES) = make_uint4(0u, 0u, ~0u, 0u);
  __syncthreads();
  run_phase<PH>(p, lds);
}

constexpr size_t OFF_TS = 20480;
template <int PH> __device__ __forceinline__ void run_all(const Params& p, char* lds, const XcdBarrier& bar) {
#if PROBE_T
  if (blockIdx.x == 0 && threadIdx.x == 0) ((unsigned long long*)(p.ws + OFF_TS))[PH] = __builtin_amdgcn_s_memrealtime();
#endif
  run_phase<PH>(p, lds);
  if constexpr (PH + 1 < NPHASE) { xcd_barrier(bar); run_all<PH + 1>(p, lds, bar); }
}
__global__ void __launch_bounds__(NTHR, 2) k_mega(Params p) {
  extern __shared__ __attribute__((aligned(16))) char lds[];
  uint4* xbw = reinterpret_cast<uint4*>(lds + LDS_BYTES);
  if (threadIdx.x == 0) {
    const unsigned x = xb_xcc_id();
    const unsigned r = xb_add((unsigned*)(p.ws + OFF_XCENSUS) + x, 1u);
    *xbw = make_uint4(0u, 0u, x, r);
  }
  __syncthreads();
  XcdBarrier bar = xcd_barrier_post((unsigned*)(p.ws + OFF_BAR), (volatile LAS unsigned*)xbw);
  run_all<0>(p, lds, bar);
#if PROBE_T
  xcd_barrier(bar);
  if (blockIdx.x == 0 && threadIdx.x == 0) ((unsigned long long*)(p.ws + OFF_TS))[NPHASE] = __builtin_amdgcn_s_memrealtime();
  xcd_barrier(bar);
  {
    const unsigned long long* ts = (const unsigned long long*)(p.ws + OFF_TS);
    const float v1 = (float)(ts[PROBE_A1] - ts[PROBE_A0]) * 0.01f * PROBE_SCALE;
    for (size_t i = (size_t)blockIdx.x * NTHR + threadIdx.x; i < (size_t)NTOK * DM; i += (size_t)gridDim.x * NTHR) p.out[i] = (i == 0) ? v1 : 1.f;
  }
#endif
}

#if DBG
__device__ __forceinline__ void dbg_max(float* slot, float v) { atomicMax((unsigned*)slot, __float_as_uint(v)); }
__global__ void chk_gemm(const bf16_t* A, int lda, const float* W, int ldw, int K, int N, const float* Cf, const bf16_t* Cb, int ldc, int mode, const Params p, float* slot, float scale) {
  const int s = blockIdx.x * blockDim.x + threadIdx.x;
  const int t = (int)(((unsigned)s * 2654435761u) % NTOK), n = (int)(((unsigned)s * 40503u + 17u) % (unsigned)N);
  float ref = 0.f;
  for (int k = 0; k < K; ++k) ref += bf2f(A[(size_t)t * lda + k]) * W[(size_t)k * ldw + n];
  float got;
  if (mode == 0) got = Cf[(size_t)t * ldc + n];
  else if (mode == 1) { got = Cf[(size_t)t * ldc + n]; ref = (ref + p.pool_b[n]) * p.pool_scale[n] + ALPHA * p.x[(size_t)t * DM + n]; }
  else if (mode == 2) { got = Cf[(size_t)t * ldc + n] - ALPHA * ((const float*)(p.ws + OFF_H1F))[(size_t)t * DM + n]; }
  else if (mode == 3) got = bf2f(Cb[(size_t)t * ldc + n]);
  else if (mode == 4) got = bf2f(Cb[(size_t)t * ldc + (n >> 7) * 192 + (n & 127)]);
  else {
    const int h = n / 192, d = n % 192;
    got = bf2f(Cb[(size_t)t * ldc + n]);
    if (d >= 128) {
      const int j = (d - 128) & 31; const bool second = d >= 160;
      const int n1 = h * 192 + 128 + j, n2 = n1 + 32;
      float x1 = 0.f, x2 = 0.f;
      for (int k = 0; k < K; ++k) { const float a = bf2f(A[(size_t)t * lda + k]); x1 += a * W[(size_t)k * ldw + n1]; x2 += a * W[(size_t)k * ldw + n2]; }
      const int pos = t & (SEQ - 1);
      const double inv = pow(10000.0, -(double)(2 * j) / 64.0), ang = pos * inv;
      const float c = (float)cos(ang), sn = (float)sin(ang);
      ref = second ? x1 * sn + x2 * c : x1 * c - x2 * sn;
    }
  }
  dbg_max(slot, fabsf(got - ref) / (fabsf(ref) + scale));
}
__global__ void chk_pool(const Params p, float* slot) {
  const int s = blockIdx.x * blockDim.x + threadIdx.x;
  const int t = (int)(((unsigned)s * 2654435761u) % NTOK), n = (int)(((unsigned)s * 40503u + 17u) % DM);
  const int g = n >> 8, half = 1 << g, pos = t & (SEQ - 1), tb = t - pos;
  const float* x = p.x; const bf16_t* pooled = (const bf16_t*)(p.ws + OFF_POOLED);
  float ref = 0.f;
  for (int k = 0; k < 256; ++k) {
    const int c = g * 256 + k; float sum = 0.f; int cn = 0;
    for (int r = pos - half; r < pos + half; ++r) if (r >= 0 && r < SEQ) { sum += x[(size_t)(tb + r) * DM + c]; ++cn; }
    const float pl = sum / cn - x[(size_t)t * DM + c];
    if (k == (n & 255)) dbg_max(slot, fabsf(bf2f(pooled[(size_t)t * DM + c]) - pl) / (fabsf(pl) + 0.5f));
    ref += pl * p.pool_w[((size_t)g * 256 + k) * 256 + (n & 255)];
  }
  ref = (ref + p.pool_b[n]) * p.pool_scale[n] + ALPHA * x[(size_t)t * DM + n];
  dbg_max(slot + 1, fabsf(((const float*)(p.ws + OFF_Z))[(size_t)t * DM + n] - ref) / (fabsf(ref) + 0.5f));
}
__global__ void chk_route(const Params p, int layer, float* slot) {
  const int s = blockIdx.x * blockDim.x + threadIdx.x;
  const int t = (int)(((unsigned)s * 2654435761u) % NTOK);
  const float* lg = (const float*)(p.ws + OFF_LOGIT) + (size_t)t * NEXP;
  const float* rb = p.router_b + layer * NEXP;
  float gs[8];
  for (int g = 0; g < 8; ++g) { float m1 = -1e30f, m2 = -1e30f; for (int k = 0; k < 32; ++k) { const float v = 1.f / (1.f + expf(-lg[g * 32 + k])) + rb[g * 32 + k]; if (v > m1) { m2 = m1; m1 = v; } else if (v > m2) m2 = v; } gs[g] = m1 + m2; }
  bool sel[8];
  for (int g = 0; g < 8; ++g) { int rank = 0; for (int g2 = 0; g2 < 8; ++g2) rank += (gs[g2] > gs[g] || (gs[g2] == gs[g] && g2 < g)); sel[g] = rank < 4; }
  int ei[8]; float es[8]; float ssum = 0.f; unsigned long long used[4] = {0, 0, 0, 0};
  for (int kk = 0; kk < 8; ++kk) { float best = -1e30f; int bi = -1;
    for (int e = 0; e < 256; ++e) { if (!sel[e >> 5] || ((used[e >> 6] >> (e & 63)) & 1)) continue; const float v = 1.f / (1.f + expf(-lg[e])) + rb[e]; if (v > best) { best = v; bi = e; } }
    used[bi >> 6] |= 1ull << (bi & 63); ei[kk] = bi; es[kk] = 1.f / (1.f + expf(-lg[bi])); ssum += es[kk]; }
  const int* texp = (const int*)(p.ws + OFF_TEXP); const float* gate = (const float*)(p.ws + OFF_GATE);
  float err = 0.f;
  for (int kk = 0; kk < 8; ++kk) { if (texp[t * 8 + kk] != ei[kk]) err = 10.f; err = fmaxf(err, fabsf(gate[t * 8 + kk] - es[kk] / ssum * 2.5f)); }
  const int* cnt = (const int*)(p.ws + OFF_CNTP) + layer * NEXP * CNT_STRIDE; const int* list = (const int*)(p.ws + OFF_LIST);
  const int e = s & 255; const int c = cnt[e * CNT_STRIDE];
  if (c > 0) { const int idx = (int)(((unsigned)s * 7919u) % (unsigned)c); const int ent = list[(size_t)e * NTOK + idx]; if (ent < 0 || ent >= NTOK * 8 || texp[ent] != e) err = 20.f; }
  if (s == 0) { int tot = 0; for (int i = 0; i < 256; ++i) tot += cnt[i * CNT_STRIDE]; if (tot != NTOK * 8) err = 30.f; }
  dbg_max(slot, err);
}
__global__ void chk_moe(const Params p, int layer, float* slot) {
  __shared__ float hbs[256];
  const int s = blockIdx.x; const int t = (int)(((unsigned)s * 2654435761u + 12345u) % NTOK), k = s % 9;
  const bf16_t* h = (const bf16_t*)(p.ws + OFF_H0B) + (size_t)t * DM;
  const int* texp = (const int*)(p.ws + OFF_TEXP); const float* gate = (const float*)(p.ws + OFF_GATE);
  const float *wg, *wu, *wd; float g = 1.f; const bf16_t* y;
  if (k == 8) { wg = p.sw_gate + (size_t)layer * DM * EFF; wu = p.sw_up + (size_t)layer * DM * EFF; wd = p.sw_down + (size_t)layer * EFF * DM; y = (const bf16_t*)(p.ws + OFF_YSH) + (size_t)t * DM; }
  else { const int e = texp[t * 8 + k]; const size_t eo = (size_t)layer * NEXP + e; wg = p.ew_gate + eo * DM * EFF; wu = p.ew_up + eo * DM * EFF; wd = p.ew_down + eo * EFF * DM; g = gate[t * 8 + k]; y = (const bf16_t*)(p.ws + OFF_Y) + ((size_t)t * 8 + k) * DM; }
  const int f = threadIdx.x; float a = 0.f, b = 0.f;
  for (int d = 0; d < DM; ++d) { const float hv = bf2f(h[d]); a += hv * wg[(size_t)d * EFF + f]; b += hv * wu[(size_t)d * EFF + f]; }
  hbs[f] = a / (1.f + expf(-a)) * b;
  __syncthreads();
  for (int n = f; n < DM; n += 256) { float r = 0.f; for (int ff = 0; ff < EFF; ++ff) r += hbs[ff] * wd[(size_t)ff * DM + n]; r *= g;
    dbg_max(slot, fabsf(bf2f(y[n]) - r) / (fabsf(r) + 0.05f)); }
}
__global__ void chk_ln(const Params p, const float* zin, int combine, const float* hres, const float* g, const float* b, const float* of, float* slot) {
  const int s = blockIdx.x * blockDim.x + threadIdx.x; const int t = (int)(((unsigned)s * 2654435761u + 99u) % NTOK);
  const bf16_t* Y = (const bf16_t*)(p.ws + OFF_Y); const bf16_t* Ysh = (const bf16_t*)(p.ws + OFF_YSH);
  double mu = 0, var = 0;
  auto val = [&](int c) -> float { if (!combine) return zin[(size_t)t * DM + c]; float v = ALPHA * hres[(size_t)t * DM + c] + bf2f(Ysh[(size_t)t * DM + c]); for (int k = 0; k < 8; ++k) v += bf2f(Y[((size_t)t * 8 + k) * DM + c]); return v; };
  for (int c = 0; c < DM; ++c) mu += val(c);
  mu /= DM;
  for (int c = 0; c < DM; ++c) { const double d = val(c) - mu; var += d * d; }
  var /= DM; const float rstd = (float)(1.0 / sqrt(var + 1e-5));
  float err = 0.f;
  for (int c = 0; c < DM; c += 7) { const float ref = (float)(val(c) - mu) * rstd * g[c] + b[c]; err = fmaxf(err, fabsf(of[(size_t)t * DM + c] - ref) / (fabsf(ref) + 0.5f)); }
  dbg_max(slot, err);
}
__global__ void chk_mla_rows(const Params p, float* slot) {
  const int s = blockIdx.x * blockDim.x + threadIdx.x; const int t = (int)(((unsigned)s * 2654435761u + 7u) % NTOK);
  const float* a = (const float*)(p.ws + OFF_ABUF) + (size_t)t * WA_NP;
  const bf16_t* ql = (const bf16_t*)(p.ws + OFF_QLAT) + (size_t)t * QL; const bf16_t* kvl = (const bf16_t*)(p.ws + OFF_KVLAT) + (size_t)t * KVL; const bf16_t* Kb = (const bf16_t*)(p.ws + OFF_K) + (size_t)t * 1536;
  double sq = 0, sk = 0; for (int i = 0; i < QL; ++i) sq += (double)a[i] * a[i]; for (int i = 0; i < KVL; ++i) sk += (double)a[QL + i] * a[QL + i];
  const float rq = (float)(1.0 / sqrt(sq / QL + 1e-6)), rk = (float)(1.0 / sqrt(sk / KVL + 1e-6));
  float err = 0.f;
  for (int i = 0; i < QL; ++i) { const float r = a[i] * rq * p.qn_g[i]; err = fmaxf(err, fabsf(bf2f(ql[i]) - r) / (fabsf(r) + 0.5f)); }
  for (int i = 0; i < KVL; ++i) { const float r = a[QL + i] * rk * p.kvn_g[i]; err = fmaxf(err, fabsf(bf2f(kvl[i]) - r) / (fabsf(r) + 0.5f)); }
  const int pos = t & (SEQ - 1);
  for (int j = 0; j < 32; ++j) { const double inv = pow(10000.0, -(double)(2 * j) / 64.0), ang = pos * inv; const float c = (float)cos(ang), sn = (float)sin(ang);
    const float x1 = a[640 + j], x2 = a[672 + j]; const float r1 = x1 * c - x2 * sn, r2 = x1 * sn + x2 * c;
    for (int h = 0; h < NH; h += 3) { err = fmaxf(err, fabsf(bf2f(Kb[h * 192 + 128 + j]) - r1) / (fabsf(r1) + 0.5f)); err = fmaxf(err, fabsf(bf2f(Kb[h * 192 + 160 + j]) - r2) / (fabsf(r2) + 0.5f)); } }
  dbg_max(slot, err);
}
__global__ void chk_attn(const Params p, float* slot) {
  __shared__ float red[256]; __shared__ float qs[192]; __shared__ float osum[128];
  const int s = blockIdx.x; const int t = (int)(((unsigned)s * 2654435761u + 5u) % NTOK), h = s & 7;
  const int b = t >> 13; const size_t t0 = (size_t)b * SEQ;
  const bf16_t* Q = (const bf16_t*)(p.ws + OFF_Q) + (size_t)t * 1536 + h * 192;
  const bf16_t* Kb = (const bf16_t*)(p.ws + OFF_K) + t0 * 1536 + h * 192; const bf16_t* V = (const bf16_t*)(p.ws + OFF_V) + t0 * 1024 + h * 128;
  const bf16_t* O = (const bf16_t*)(p.ws + OFF_O) + (size_t)t * 1024 + h * 128;
  const int tid = threadIdx.x;
  if (tid < 192) qs[tid] = bf2f(Q[tid]); if (tid < 128) osum[tid] = 0.f;
  __syncthreads();
  float sc[32]; float mx = -1e30f;
  for (int i = 0; i < 32; ++i) { const int key = tid + 256 * i; float d = 0.f; for (int c = 0; c < 192; ++c) d += qs[c] * bf2f(Kb[(size_t)key * 1536 + c]); sc[i] = d * 0.07216878364870323f; mx = fmaxf(mx, sc[i]); }
  red[tid] = mx; __syncthreads();
  for (int o = 128; o > 0; o >>= 1) { if (tid < o) red[tid] = fmaxf(red[tid], red[tid + o]); __syncthreads(); }
  mx = red[0]; __syncthreads();
  float sum = 0.f; for (int i = 0; i < 32; ++i) { sc[i] = expf(sc[i] - mx); sum += sc[i]; }
  red[tid] = sum; __syncthreads();
  for (int o = 128; o > 0; o >>= 1) { if (tid < o) red[tid] += red[tid + o]; __syncthreads(); }
  sum = red[0]; __syncthreads();
  for (int d = 0; d < 128; ++d) { float a = 0.f; for (int i = 0; i < 32; ++i) a += sc[i] * bf2f(V[(size_t)(tid + 256 * i) * 1024 + d]); atomicAdd(&osum[d], a); }
  __syncthreads();
  if (tid < 128) { const float r = osum[tid] / sum; dbg_max(slot, fabsf(bf2f(O[tid]) - r) / (fabsf(r) + 0.01f)); }
}
__global__ void dbg_report(const float* err, int nstage, float tol, float* out, int n) {
  int first = -1;
  for (int i = 0; i < nstage; ++i) if (i != 2 && !(err[i] <= tol)) { first = i; break; }
  if (first < 0) return;
  float e = err[first]; float m = 1.f + 2.f * log10f(fmaxf(e / tol, 1.f)); if (!(m < 9.5f)) m = 9.5f;
  const float v = m * powf(10.f, 3.f + first);
  for (int i = blockIdx.x * blockDim.x + threadIdx.x; i < n; i += gridDim.x * blockDim.x) out[i] = v;
}
#endif

template <int PH> static void launch_phase(const Params& p, int grid, hipStream_t stream) {
  static bool attr = false;
  if (!attr) { hipFuncSetAttribute((const void*)k_phase<PH>, hipFuncAttributeMaxDynamicSharedMemorySize, LDS_BYTES + 16); attr = true; }
  hipLaunchKernelGGL(k_phase<PH>, dim3(grid), dim3(NTHR), LDS_BYTES + 16, stream, p);
}
template <int PH> static void launch_range(const Params& p, int grid, hipStream_t stream, int last) {
  if (PH <= last) { launch_phase<PH>(p, grid, stream); if ((REP_MASK >> PH) & 1) launch_phase<PH>(p, grid, stream); }
  if constexpr (PH + 1 < NPHASE) launch_range<PH + 1>(p, grid, stream, last);
}

extern "C" void kernel_launch(void* const* d_in, const int* in_sizes, int n_in, void* d_out, int out_size, void* d_ws, size_t ws_size, hipStream_t stream) {
  static int grid = 0;
  if (!grid) {
    int dev = 0, cus = 0; hipGetDevice(&dev); hipDeviceGetAttribute(&cus, hipDeviceAttributeMultiprocessorCount, dev);
    if (cus <= 0) cus = 256;
    hipFuncSetAttribute((const void*)k_mega, hipFuncAttributeMaxDynamicSharedMemorySize, LDS_BYTES + 16);
    int per_cu = 0; hipOccupancyMaxActiveBlocksPerMultiprocessor(&per_cu, k_mega, NTHR, LDS_BYTES + 16);
    if (per_cu < 1) fprintf(stderr, "kernel_launch: occupancy query says %d blocks/CU\n", per_cu);
    grid = cus;
    if (ws_size < WS_END) fprintf(stderr, "kernel_launch: workspace too small: %zu < %zu\n", ws_size, WS_END);
  }
  Params p{};
  const float* const* in = (const float* const*)d_in;
  p.x = in[0]; p.pool_w = in[1]; p.pool_b = in[2]; p.pool_scale = in[3]; p.w_a = in[4]; p.qn_g = in[5]; p.kvn_g = in[6]; p.w_uq = in[7]; p.w_uk = in[8]; p.w_uv = in[9]; p.w_o = in[10];
  p.ln_mix_g = in[11]; p.ln_mix_b = in[12]; p.router_w = in[13]; p.router_b = in[14]; p.ew_gate = in[15]; p.ew_up = in[16]; p.ew_down = in[17];
  p.sw_gate = in[18]; p.sw_up = in[19]; p.sw_down = in[20]; p.ln_ffn_g = in[21]; p.ln_ffn_b = in[22];
  p.out = (float*)d_out; p.ws = (char*)d_ws;
  hipMemsetAsync((char*)d_ws + OFF_BAR, 0, 32768, stream);
#if MK_SINGLE
  hipLaunchKernelGGL(k_mega, dim3(grid), dim3(NTHR), LDS_BYTES + 16, stream, p);
#else
  launch_range<0>(p, grid, stream, NPHASE - 1);
#endif
#if DBG
  {
    char* ws = (char*)d_ws; float* err = (float*)(ws + OFF_DBG);
    const bf16_t* h0b = (const bf16_t*)(ws + OFF_H0B); const bf16_t* h1b = (const bf16_t*)(ws + OFF_H1B);
    chk_gemm<<<16, 256, 0, stream>>>(h0b, DM, p.router_w + (size_t)DM * NEXP, NEXP, DM, NEXP, (const float*)(ws + OFF_LOGIT), nullptr, NEXP, 0, p, err + 0, 0.5f);
    chk_route<<<16, 256, 0, stream>>>(p, 1, err + 1);
    chk_moe<<<72, 256, 0, stream>>>(p, 1, err + 2);
    chk_ln<<<4, 64, 0, stream>>>(p, nullptr, 1, (const float*)(ws + OFF_H0F), p.ln_ffn_g + DM, p.ln_ffn_b + DM, p.out, err + 3);
    chk_gemm<<<16, 256, 0, stream>>>(h1b, DM, p.w_a, WA_N, DM, WA_N, (const float*)(ws + OFF_ABUF), nullptr, WA_NP, 0, p, err + 4, 0.5f);
    chk_mla_rows<<<4, 64, 0, stream>>>(p, err + 5);
    chk_gemm<<<16, 256, 0, stream>>>((const bf16_t*)(ws + OFF_QLAT), QL, p.w_uq, 1536, QL, 1536, nullptr, (const bf16_t*)(ws + OFF_Q), 1536, 5, p, err + 6, 0.5f);
    chk_gemm<<<16, 256, 0, stream>>>((const bf16_t*)(ws + OFF_KVLAT), KVL, p.w_uk, 1024, KVL, 1024, nullptr, (const bf16_t*)(ws + OFF_K), 1536, 4, p, err + 7, 0.5f);
    chk_gemm<<<16, 256, 0, stream>>>((const bf16_t*)(ws + OFF_KVLAT), KVL, p.w_uv, 1024, KVL, 1024, nullptr, (const bf16_t*)(ws + OFF_V), 1024, 3, p, err + 8, 0.25f);
    chk_attn<<<64, 256, 0, stream>>>(p, err + 9);
    chk_gemm<<<16, 256, 0, stream>>>((const bf16_t*)(ws + OFF_O), DM, p.w_o, DM, DM, DM, (const float*)(ws + OFF_Z), nullptr, DM, 2, p, err + 10, 0.003f);
    chk_ln<<<4, 64, 0, stream>>>(p, (const float*)(ws + OFF_Z), 0, nullptr, p.ln_mix_g + DM, p.ln_mix_b + DM, (const float*)(ws + OFF_H0F), err + 11);
    dbg_report<<<256, 256, 0, stream>>>(err, 12, 0.03f, p.out, out_size);
  }
#endif
  const hipError_t le = hipPeekAtLastError();
  if (le != hipSuccess) fprintf(stderr, "kernel_launch: launch failed: %s\n", hipGetErrorName(le));
}
```
